# Optimizing an MI355X kernel written in HIP

```python
import jax, jax.numpy as jnp
from jax import lax
import numpy as np

D_MODEL = 2048
BATCH = 32
SEQ = 256
DEPTH = 1
DEC_BATCH = 2
DEC_SEQ = 2048
PAST_LEN = 512

GRID_W = 64
MIX_DIM = D_MODEL
RET_DIM = MIX_DIM // 2
MLSTM_DIM = MIX_DIM - RET_DIM
HEAD_DIM = 256
RET_HEADS = RET_DIM // HEAD_DIM
MLSTM_HEADS = MLSTM_DIM // HEAD_DIM
D_FF = ((8 * D_MODEL // 3 + 127) // 128) * 128
CONV_W = 3
CHUNK = 128
ROPE_BASE = 10000.0
N_IN = 4 * RET_DIM + 4 * MLSTM_DIM + 4 * MLSTM_HEADS
ALPHA = (2.0 * DEPTH) ** 0.25
BETA = (8.0 * DEPTH) ** -0.25

kernel_name = 'hybrid_retention_mlstm_flow_step'

F32 = jnp.float32


def _ln(x, eps=1e-6):
    xf = x.astype(F32)
    mu = jnp.mean(xf, axis=-1, keepdims=True)
    var = jnp.mean(jnp.square(xf - mu), axis=-1, keepdims=True)
    return ((xf - mu) * lax.rsqrt(var + eps)).astype(x.dtype)


def _seq_conv(u, w, grid):
    B, L, C = u.shape
    if grid:
        rows = L // GRID_W
        u = u.reshape(B * rows, GRID_W, C)
    n = u.shape[1]
    p = CONV_W // 2
    up = jnp.pad(u, ((0, 0), (p, p), (0, 0)))
    y = up[:, 0:n] * w[0]
    for t in range(1, CONV_W):
        y = y + up[:, t:t + n] * w[t]
    return y.reshape(B, L, C)


def _rope_2d(x):
    L, hd = x.shape[1], x.shape[-1]
    quarter = hd // 4
    half = hd // 2
    t = jnp.arange(L)
    row = (t // GRID_W).astype(F32)
    col = (t % GRID_W).astype(F32)
    inv = ROPE_BASE ** (-jnp.arange(quarter, dtype=F32) / quarter)

    def rot(xh, pos):
        ang = pos[:, None] * inv
        cos = jnp.cos(ang)[None, :, None, :].astype(x.dtype)
        sin = jnp.sin(ang)[None, :, None, :].astype(x.dtype)
        x1, x2 = xh[..., :quarter], xh[..., quarter:]
        return jnp.concatenate([x1 * cos - x2 * sin, x1 * sin + x2 * cos], axis=-1)

    return jnp.concatenate([rot(x[..., :half], row), rot(x[..., half:], col)], axis=-1)


def _to_chunks(a):
    B, L, H, d = a.shape
    return a.astype(F32).reshape(B, L // CHUNK, CHUNK, H, d).transpose(1, 0, 3, 2, 4)


def _gate_chunks(a):
    B, L, H = a.shape
    return a.astype(F32).reshape(B, L // CHUNK, CHUNK, H).transpose(1, 0, 3, 2)


def _from_chunks(o, B, L):
    H, d = o.shape[2], o.shape[-1]
    return o.transpose(1, 0, 3, 2, 4).reshape(B, L, H, d)


def _retention_dir(q, k, v, log_gamma, s0):
    B, L = q.shape[0], q.shape[1]
    pos = jnp.arange(CHUNK, dtype=F32)
    diff = pos[:, None] - pos[None, :]
    lg = log_gamma.astype(F32)
    dmask = jnp.where(diff >= 0, jnp.exp(lg[:, None, None] * jnp.maximum(diff, 0.0)), 0.0)
    q_dec = jnp.exp(lg[:, None] * (pos + 1.0))[..., None]
    k_dec = jnp.exp(lg[:, None] * (CHUNK - 1.0 - pos))[..., None]
    c_dec = jnp.exp(lg * CHUNK)[:, None, None]

    def step(s, xs):
        qb, kb, vb = xs
        att = jnp.einsum('bhik,bhjk->bhij', qb, kb) * dmask
        o = jnp.einsum('bhij,bhjv->bhiv', att, vb) + jnp.einsum('bhik,bhkv->bhiv', qb, s) * q_dec
        s = s * c_dec + jnp.einsum('bhjk,bhjv->bhkv', kb * k_dec, vb)
        return s, o

    s_fin, o = lax.scan(step, s0.astype(F32), (_to_chunks(q), _to_chunks(k), _to_chunks(v)))
    return _from_chunks(o, B, L).astype(q.dtype), s_fin


def _mlstm_dir(q, k, v, i_pre, log_f, c0, n0, m0):
    B, L = q.shape[0], q.shape[1]
    pos = jnp.arange(CHUNK)
    causal = pos[:, None] >= pos[None, :]

    def step(carry, xs):
        C, nv, m = carry
        qb, kb, vb, ib, fb = xs
        b = jnp.cumsum(fb, axis=-1)
        dm = jnp.where(causal, b[..., :, None] - b[..., None, :] + ib[..., None, :], -jnp.inf)
        inter = b + m[..., None]
        m_t = jnp.maximum(inter, jnp.max(dm, axis=-1))
        w = jnp.exp(dm - m_t[..., None])
        sp = jnp.exp(inter - m_t)
        s = jnp.einsum('bhik,bhjk->bhij', qb, kb) * w
        num = jnp.einsum('bhij,bhjv->bhiv', s, vb) + jnp.einsum('bhik,bhkv->bhiv', qb, C) * sp[..., None]
        den = jnp.sum(s, axis=-1) + jnp.einsum('bhik,bhk->bhi', qb, nv) * sp
        h = num / jnp.maximum(jnp.abs(den), jnp.exp(-m_t))[..., None]
        b_last = b[..., -1]
        g = b_last[..., None] - b + ib
        m_new = jnp.maximum(b_last + m, jnp.max(g, axis=-1))
        wk = jnp.exp(g - m_new[..., None])
        sc = jnp.exp(b_last + m - m_new)
        C = C * sc[..., None, None] + jnp.einsum('bhjk,bhjv->bhkv', kb * wk[..., None], vb)
        nv = nv * sc[..., None] + jnp.einsum('bhjk,bhj->bhk', kb, wk)
        return (C, nv, m_new), h

    (c_fin, n_fin, m_fin), h = lax.scan(
        step, (c0.astype(F32), n0.astype(F32), m0.astype(F32)),
        (_to_chunks(q), _to_chunks(k), _to_chunks(v), _gate_chunks(i_pre), _gate_chunks(log_f)))
    return _from_chunks(h, B, L).astype(q.dtype), c_fin, n_fin, m_fin


def _mixer(h, grid, s_ret0, c0, n0, m0, w_in, b_gate, conv_qk, ret_theta, gn_ret, gn_mlstm, w_out):
    B, L, _ = h.shape
    R, M, HM = RET_DIM, MLSTM_DIM, MLSTM_HEADS
    proj = h @ w_in
    rq, rk, rv, rg = (proj[..., i * R:(i + 1) * R] for i in range(4))
    off = 4 * R
    mq, mk, mv, mo = (proj[..., off + i * M:off + (i + 1) * M] for i in range(4))
    gates = (proj[..., off + 4 * M:] + b_gate).astype(F32).reshape(B, L, 4, HM)

    rq = rq.reshape(B, L, RET_HEADS, HEAD_DIM)
    rk = rk.reshape(B, L, RET_HEADS, HEAD_DIM) * (HEAD_DIM ** -0.5)
    rv = rv.reshape(B, L, RET_HEADS, HEAD_DIM)
    if grid:
        rq, rk = _rope_2d(rq), _rope_2d(rk)
    log_gamma = jax.nn.log_sigmoid(ret_theta.astype(F32))
    o_f, s_f = _retention_dir(rq, rk, rv, log_gamma[0], s_ret0[:, 0])
    o_b, s_b = _retention_dir(rq[:, ::-1], rk[:, ::-1], rv[:, ::-1], log_gamma[1], s_ret0[:, 1])
    ret_out = (_ln(o_f + o_b[:, ::-1]) * gn_ret).reshape(B, L, R) * jax.nn.silu(rg)

    qk = jax.nn.silu(_seq_conv(jnp.concatenate([mq, mk], axis=-1), conv_qk, grid))
    mq = qk[..., :M].reshape(B, L, HM, HEAD_DIM)
    mk = qk[..., M:].reshape(B, L, HM, HEAD_DIM) * (HEAD_DIM ** -0.5)
    mv = mv.reshape(B, L, HM, HEAD_DIM)
    i_f, lf_f = gates[:, :, 0], jax.nn.log_sigmoid(gates[:, :, 1])
    i_b, lf_b = gates[:, :, 2], jax.nn.log_sigmoid(gates[:, :, 3])
    h_f, cf, nf, mf = _mlstm_dir(mq, mk, mv, i_f, lf_f, c0[:, 0], n0[:, 0], m0[:, 0])
    h_b, cb, nb, mb = _mlstm_dir(mq[:, ::-1], mk[:, ::-1], mv[:, ::-1], i_b[:, ::-1], lf_b[:, ::-1],
                                 c0[:, 1], n0[:, 1], m0[:, 1])
    mlstm_out = jax.nn.sigmoid(mo) * (_ln(h_f + h_b[:, ::-1]) * gn_mlstm).reshape(B, L, M)

    out = jnp.concatenate([ret_out, mlstm_out], axis=-1) @ w_out
    states = (jnp.stack([s_f, s_b], axis=1), jnp.stack([cf, cb], axis=1),
              jnp.stack([nf, nb], axis=1), jnp.stack([mf, mb], axis=1))
    return out, states


def _ffn(h, grid, w_up, conv_ff, w_down):
    ug = h @ w_up
    u, g = ug[..., :D_FF], ug[..., D_FF:]
    return (jax.nn.silu(_seq_conv(u, conv_ff, grid)) * g) @ w_down


def _layer(x, mod, grid, s_ret0, c0, n0, m0, lp):
    (w_in, b_gate, conv_qk, ret_theta, gn_ret, gn_mlstm, w_out,
     ln1_g, ln1_b, w_up, conv_ff, w_down, ln2_g, ln2_b) = lp
    sh1, sc1, g1, sh2, sc2, g2 = jnp.split(mod, 6, axis=-1)
    h = _ln(x) * (1.0 + sc1) + sh1
    mix, states = _mixer(h, grid, s_ret0, c0, n0, m0, w_in, b_gate, conv_qk, ret_theta,
                         gn_ret, gn_mlstm, w_out)
    x = _ln(ALPHA * x + g1 * mix) * ln1_g + ln1_b
    h = _ln(x) * (1.0 + sc2) + sh2
    x = _ln(ALPHA * x + g2 * _ffn(h, grid, w_up, conv_ff, w_down)) * ln2_g + ln2_b
    return x, states


def setup_inputs(seed: int = 0) -> dict:
    key = jax.random.key(seed)
    ks = jax.random.split(key, 32)

    def nrm(k, shape, s):
        return s * jax.random.normal(k, shape, F32)

    D, HR, HM, HD = D_MODEL, RET_HEADS, MLSTM_HEADS, HEAD_DIM
    base_gamma = 1.0 - 2.0 ** (-5.0 - np.arange(HR, dtype=np.float32))
    theta0 = jnp.asarray(np.log(base_gamma / (1.0 - base_gamma)), F32)
    i_bias = nrm(ks[20], (DEPTH, 2, HM), 0.1)
    f_bias = jnp.asarray(np.linspace(3.0, 6.0, HM), F32) + nrm(ks[21], (DEPTH, 2, HM), 0.1)
    b_gate = jnp.stack([i_bias[:, 0], f_bias[:, 0], i_bias[:, 1], f_bias[:, 1]], axis=1).reshape(DEPTH, 4 * HM)
    return {
        'x_prompt': nrm(ks[0], (BATCH, SEQ, D), 1.0),
        'x_sample': nrm(ks[1], (DEC_BATCH, DEC_SEQ, D), 1.0),
        'state_ret': nrm(ks[2], (DEC_BATCH, DEPTH, 2, HR, HD, HD), 0.3),
        'state_mlstm_C': nrm(ks[3], (DEC_BATCH, DEPTH, 2, HM, HD, HD), 0.1),
        'state_mlstm_n': nrm(ks[4], (DEC_BATCH, DEPTH, 2, HM, HD), 0.1),
        'state_mlstm_m': 1.0 + nrm(ks[5], (DEC_BATCH, DEPTH, 2, HM), 0.5),
        'c': nrm(ks[6], (DEC_BATCH, D), 1.0),
        'c_ctx': nrm(ks[7], (D,), 1.0),
        'w_mod': nrm(ks[8], (DEPTH, D, 6 * D), 0.5 * D ** -0.5),
        'b_mod': nrm(ks[9], (DEPTH, 6 * D), 0.02),
        'w_in': nrm(ks[10], (DEPTH, D, N_IN), D ** -0.5),
        'b_gate': b_gate,
        'conv_qk': nrm(ks[11], (DEPTH, CONV_W, 2 * MLSTM_DIM), CONV_W ** -0.5),
        'ret_theta': theta0[None, None, :] + nrm(ks[12], (DEPTH, 2, HR), 0.05),
        'gn_ret': 1.0 + nrm(ks[13], (DEPTH, HR, HD), 0.02),
        'gn_mlstm': 1.0 + nrm(ks[14], (DEPTH, HM, HD), 0.02),
        'w_out': nrm(ks[15], (DEPTH, MIX_DIM, D), BETA * MIX_DIM ** -0.5),
        'ln1_g': 1.0 + nrm(ks[16], (DEPTH, D), 0.02),
        'ln1_b': nrm(ks[17], (DEPTH, D), 0.02),
        'w_up': nrm(ks[18], (DEPTH, D, 2 * D_FF), D ** -0.5),
        'conv_ff': nrm(ks[19], (DEPTH, CONV_W, D_FF), CONV_W ** -0.5),
        'w_down': nrm(ks[22], (DEPTH, D_FF, D), BETA * D_FF ** -0.5),
        'ln2_g': 1.0 + nrm(ks[23], (DEPTH, D), 0.02),
        'ln2_b': nrm(ks[24], (DEPTH, D), 0.02),
    }


def reference(x_prompt, x_sample, state_ret, state_mlstm_C, state_mlstm_n, state_mlstm_m, c, c_ctx,
              w_mod, b_mod, w_in, b_gate, conv_qk, ret_theta, gn_ret, gn_mlstm, w_out,
              ln1_g, ln1_b, w_up, conv_ff, w_down, ln2_g, ln2_b):
    Bp = x_prompt.shape[0]
    zero_ret = jnp.zeros((Bp, 2, RET_HEADS, HEAD_DIM, HEAD_DIM), F32)
    zero_C = jnp.zeros((Bp, 2, MLSTM_HEADS, HEAD_DIM, HEAD_DIM), F32)
    zero_n = jnp.zeros((Bp, 2, MLSTM_HEADS, HEAD_DIM), F32)
    zero_m = jnp.zeros((Bp, 2, MLSTM_HEADS), F32)
    y_prompt, y_sample = x_prompt, x_sample
    ret_list, C_list, n_list, m_list = [], [], [], []
    for l in range(DEPTH):
        lp = (w_in[l], b_gate[l], conv_qk[l], ret_theta[l], gn_ret[l], gn_mlstm[l], w_out[l],
              ln1_g[l], ln1_b[l], w_up[l], conv_ff[l], w_down[l], ln2_g[l], ln2_b[l])
        mod_ctx = (jax.nn.silu(c_ctx) @ w_mod[l] + b_mod[l])[None, None, :]
        mod_lat = (jax.nn.silu(c) @ w_mod[l] + b_mod[l])[:, None, :]
        y_prompt, st = _layer(y_prompt, mod_ctx, False, zero_ret, zero_C, zero_n, zero_m, lp)
        ret_list.append(st[0])
        C_list.append(st[1])
        n_list.append(st[2])
        m_list.append(st[3])
        y_sample, _ = _layer(y_sample, mod_lat, True, state_ret[:, l], state_mlstm_C[:, l],
                             state_mlstm_n[:, l], state_mlstm_m[:, l], lp)
    new_state_ret = jnp.stack(ret_list, axis=1)
    new_state_mlstm_C = jnp.stack(C_list, axis=1)
    new_state_mlstm_n = jnp.stack(n_list, axis=1)
    new_state_mlstm_m = jnp.stack(m_list, axis=1)
    return (y_prompt, y_sample, new_state_ret, new_state_mlstm_C, new_state_mlstm_n, new_state_mlstm_m)
```

```cpp
#include <hip/hip_runtime.h>
#include <hip/hip_cooperative_groups.h>
#include <cstdio>
#include <cstdint>
namespace pg8 {
#define PG8_LAS __attribute__((address_space(3)))
typedef unsigned short bf16_t;
typedef short bf16x8 __attribute__((ext_vector_type(8)));
typedef float f32x4 __attribute__((ext_vector_type(4)));
typedef unsigned u32x4 __attribute__((ext_vector_type(4)));
constexpr int BM = 256, BK = 64, HALF = 128, HTB = HALF * BK * 2  , STAGE_BYTES = 8 * HTB, NXCD = 8, WGM = 8;

__host__ __device__ __forceinline__ int lds_byte(int r, int c) { const int st = (r >> 4) * 2 + (c >> 5), rr = r & 15, cc = c & 31, ob = rr * 64 + cc * 2; return st * 1024 + (ob ^ (((ob >> 9) & 1) << 5)); }
__host__ __device__ __forceinline__ void stage_rc(int b, int& R, int& C) { const int st = b / 1024, sb = b % 1024, swz = sb ^ (((sb >> 9) & 1) << 5); R = (st >> 1) * 16 + swz / 64; C = (st & 1) * 32 + (swz % 64) / 2; }
__host__ __device__ __forceinline__ int perm32(int rho) { const int n = rho >> 4, i = rho & 15; return 8 * (i >> 2) + 4 * n + (i & 3); }

struct Unit { int pm, pn; };
struct Gemm { const bf16_t* A; const bf16_t* Bt; int M, N, K; };

struct StaticOrder {
    int nM, nN, nwg, G, c;
    __host__ __device__ void init(int M, int N, int G_, int c_) { nM = M / BM; nN = N / BM; nwg = nM * nN; G = G_; c = c_; }
    __host__ __device__ bool next(int i, Unit& u) const {
        const long L = (long)i * G + c; if (L >= nwg) return false;
        int wgid = (int)L; { const int q = nwg / NXCD, r = nwg % NXCD, xcd = wgid % NXCD, off = wgid / NXCD; wgid = (xcd < r ? xcd * (q + 1) : r * (q + 1) + (xcd - r) * q) + off; }
        const int nig = WGM * nN, gid = wgid / nig, fm = gid * WGM, gsz = (nM - fm) < WGM ? (nM - fm) : WGM;
        u.pm = fm + ((wgid % nig) % gsz); u.pn = (wgid % nig) / gsz; return true;
    }
    __device__ __forceinline__ void a_ready(const Unit&) const {}
    __device__ __forceinline__ void done(const Unit&) const {}
};
__device__ __forceinline__ unsigned cvt_pk_bf16(float lo, float hi) { unsigned r; asm volatile("v_cvt_pk_bf16_f32 %0, %1, %2" : "=v"(r) : "v"(lo), "v"(hi)); return r; }
template <class Epi, class Sched, bool ALIGN_EPI = false, bool SP2 = false>
__device__ __forceinline__ void gemm_phase(PG8_LAS unsigned char* lds, const Gemm g, const Sched& S, const Epi& E) {
    const int tid = threadIdx.x, wid = __builtin_amdgcn_readfirstlane(tid >> 6), lane = tid & 63, wr = wid >> 2, wc = wid & 3, fr = lane & 15, fq = lane >> 4;
    const int K = g.K, nt = K / BK;
    unsigned voffA[2], voffB[2];
#pragma unroll
    for (int i = 0; i < 2; ++i) { int R, C; stage_rc(tid * 16 + i * 8192, R, C); const int Rb = Epi::PERM ? ((R & ~31) + perm32(R & 31)) : R;
        voffA[i] = (unsigned)(R * K + C) * 2u; voffB[i] = (unsigned)(Rb * K + C) * 2u; }
    const size_t kstep = (size_t)(BK * 2);
    const size_t hstep = (size_t)HALF * K * 2;
    const size_t tstep = 2 * hstep;
    const unsigned ldsw = (unsigned)wid * 1024u;
    const int aoff = lds_byte(wr * 64 + fr, fq * 8), boff = lds_byte(wc * 32 + fr, fq * 8);
#define PG8_SA(b, h) (((b) * 2 + (h)) * HTB)
#define PG8_SB(b, h) ((4 + (b) * 2 + (h)) * HTB)
#define PG8_STAGE(bufoff, gbase, voff) do { _Pragma("unroll") for (int _i = 0; _i < 2; ++_i) \
        __builtin_amdgcn_global_load_lds((const unsigned*)((const char*)(gbase) + (voff)[_i]), (PG8_LAS unsigned*)(lds + (bufoff) + ldsw + _i * 8192), 16, 0, 0); } while (0)
#define PG8_LDA(dst, b, h) do { _Pragma("unroll") for (int m = 0; m < 4; ++m) _Pragma("unroll") for (int k = 0; k < 2; ++k) dst[m][k] = *(const PG8_LAS bf16x8*)(lds + PG8_SA(b, h) + aoff + m * 2048 + k * 1024); } while (0)
#define PG8_LDB(dst, b, h) do { _Pragma("unroll") for (int n = 0; n < 2; ++n) _Pragma("unroll") for (int k = 0; k < 2; ++k) dst[n][k] = *(const PG8_LAS bf16x8*)(lds + PG8_SB(b, h) + boff + n * 2048 + k * 1024); } while (0)
#define PG8_MMA(ai, bj, At, Bt) do { __builtin_amdgcn_s_setprio(1); _Pragma("unroll") for (int m = 0; m < 4; ++m) _Pragma("unroll") for (int n = 0; n < 2; ++n) _Pragma("unroll") for (int k = 0; k < 2; ++k) \
        acc[ai][bj][m][n] = __builtin_amdgcn_mfma_f32_16x16x32_bf16(Bt[n][k], At[m][k], acc[ai][bj][m][n], 0, 0, 0); __builtin_amdgcn_s_setprio(0); } while (0)
#define PG8_WAIT_V(n) asm volatile("s_waitcnt vmcnt(" #n ")" ::: "memory")
#define PG8_WAIT_L(n) asm volatile("s_waitcnt lgkmcnt(" #n ")" ::: "memory")
#define PG8_BAR __builtin_amdgcn_s_barrier()
#define PG8_SCHED __builtin_amdgcn_sched_barrier(0)
    Unit cur, nxt; int ui = 0;
    if (!S.next(0, cur)) return;
    f32x4 acc[2][2][4][2];
#pragma unroll
    for (int a = 0; a < 2; ++a)
#pragma unroll
        for (int b = 0; b < 2; ++b)
#pragma unroll
            for (int m = 0; m < 4; ++m)
#pragma unroll
                for (int n = 0; n < 2; ++n) acc[a][b][m][n] = (f32x4){0.f, 0.f, 0.f, 0.f};
    bf16x8 At[4][2], B0[2][2], B1[2][2];
    const char* cA = (const char*)g.A + (size_t)cur.pm * tstep; const char* cB = (const char*)g.Bt + (size_t)cur.pn * tstep;
    S.a_ready(cur);
    if constexpr (SP2) {
        PG8_STAGE(PG8_SB(0, 0), cB, voffB); PG8_STAGE(PG8_SB(0, 1), cB + hstep, voffB); PG8_STAGE(PG8_SA(0, 0), cA, voffA); PG8_STAGE(PG8_SA(0, 1), cA + hstep, voffA);
        if (wr == 1) PG8_BAR;
        PG8_WAIT_V(2); PG8_BAR;
        PG8_STAGE(PG8_SB(1, 0), cB + kstep, voffB); PG8_STAGE(PG8_SA(1, 0), cA + kstep, voffA); PG8_STAGE(PG8_SB(1, 1), cB + hstep + kstep, voffB);
        PG8_WAIT_V(6); PG8_BAR;
    } else {
        PG8_STAGE(PG8_SB(0, 0), cB, voffB); PG8_STAGE(PG8_SA(0, 0), cA, voffA); PG8_STAGE(PG8_SB(0, 1), cB + hstep, voffB); PG8_STAGE(PG8_SA(0, 1), cA + hstep, voffA);
        if (wr == 1) PG8_BAR;
        PG8_WAIT_V(4); PG8_BAR;
        PG8_STAGE(PG8_SB(1, 0), cB + kstep, voffB); PG8_STAGE(PG8_SA(1, 0), cA + kstep, voffA); PG8_STAGE(PG8_SB(1, 1), cB + hstep + kstep, voffB);
        PG8_WAIT_V(6); PG8_BAR;
    }
    for (;;) {
        const bool has_next = S.next(ui + 1, nxt);
        const char* nA = has_next ? (const char*)g.A + (size_t)nxt.pm * tstep : cA; const char* nB = has_next ? (const char*)g.Bt + (size_t)nxt.pn * tstep : cB;
        for (int t = 0; t < nt; t += 2) {
            const bool last = (t == nt - 2);
            const char* a1 = cA + (size_t)(t + 1) * kstep;
            const char* a2 = last ? nA : cA + (size_t)(t + 2) * kstep; const char* b2 = last ? nB : cB + (size_t)(t + 2) * kstep;
            const char* a3 = a2 + kstep; const char* b3 = b2 + kstep;
            if (last && has_next) S.a_ready(nxt);
            if constexpr (SP2) {
            PG8_LDB(B0, 0, 0); PG8_LDB(B1, 0, 1); PG8_SCHED; PG8_LDA(At, 0, 0); PG8_STAGE(PG8_SA(1, 1), a1 + hstep, voffA);
            PG8_WAIT_V(8); PG8_WAIT_L(0); PG8_BAR; PG8_MMA(0, 0, At, B0); PG8_MMA(0, 1, At, B1); PG8_BAR; PG8_SCHED;
            PG8_LDA(At, 0, 1); PG8_STAGE(PG8_SB(0, 0), b2, voffB); PG8_STAGE(PG8_SB(0, 1), b2 + hstep, voffB); PG8_STAGE(PG8_SA(0, 0), a2, voffA);
            PG8_WAIT_V(8); PG8_WAIT_L(0); PG8_BAR; PG8_MMA(1, 0, At, B0); PG8_MMA(1, 1, At, B1); PG8_BAR; PG8_SCHED;
            PG8_LDB(B0, 1, 0); PG8_LDB(B1, 1, 1); PG8_SCHED; PG8_LDA(At, 1, 0); PG8_STAGE(PG8_SA(0, 1), a2 + hstep, voffA);
            PG8_WAIT_V(8); PG8_WAIT_L(0); PG8_BAR; PG8_MMA(0, 0, At, B0); PG8_MMA(0, 1, At, B1); PG8_BAR; PG8_SCHED;
            PG8_LDA(At, 1, 1); PG8_STAGE(PG8_SB(1, 0), b3, voffB); PG8_STAGE(PG8_SB(1, 1), b3 + hstep, voffB); PG8_STAGE(PG8_SA(1, 0), a3, voffA);
            PG8_WAIT_V(8); PG8_WAIT_L(0); PG8_BAR; PG8_MMA(1, 0, At, B0); PG8_MMA(1, 1, At, B1); PG8_BAR; PG8_SCHED;
            } else {
            PG8_LDB(B0, 0, 0); PG8_SCHED; PG8_LDA(At, 0, 0); PG8_STAGE(PG8_SA(1, 1), a1 + hstep, voffA);
            PG8_WAIT_L(8); PG8_BAR; PG8_WAIT_L(0); PG8_MMA(0, 0, At, B0); PG8_BAR; PG8_SCHED;
            PG8_LDB(B1, 0, 1); PG8_STAGE(PG8_SB(0, 0), b2, voffB);
            PG8_BAR; PG8_WAIT_L(0); PG8_MMA(0, 1, At, B1); PG8_BAR;
            PG8_LDA(At, 0, 1); PG8_STAGE(PG8_SA(0, 0), a2, voffA);
            PG8_BAR; PG8_WAIT_L(0); PG8_MMA(1, 0, At, B0); PG8_BAR; PG8_SCHED;
            PG8_STAGE(PG8_SB(0, 1), b2 + hstep, voffB);
            PG8_WAIT_V(6); PG8_BAR; PG8_MMA(1, 1, At, B1); PG8_BAR;
            PG8_LDB(B0, 1, 0); PG8_SCHED; PG8_LDA(At, 1, 0); PG8_STAGE(PG8_SA(0, 1), a2 + hstep, voffA);
            PG8_WAIT_L(8); PG8_BAR; PG8_WAIT_L(0); PG8_MMA(0, 0, At, B0); PG8_BAR; PG8_SCHED;
            PG8_LDB(B1, 1, 1); PG8_STAGE(PG8_SB(1, 0), b3, voffB);
            PG8_BAR; PG8_WAIT_L(0); PG8_MMA(0, 1, At, B1); PG8_BAR;
            PG8_LDA(At, 1, 1); PG8_STAGE(PG8_SA(1, 0), a3, voffA);
            PG8_BAR; PG8_WAIT_L(0); PG8_MMA(1, 0, At, B0); PG8_BAR; PG8_SCHED;
            PG8_STAGE(PG8_SB(1, 1), b3 + hstep, voffB);
            PG8_WAIT_V(6); PG8_BAR; PG8_MMA(1, 1, At, B1); PG8_BAR;
            }
        }
        if constexpr (ALIGN_EPI) { if (wr == 0) PG8_BAR; }
        if constexpr (!Epi::AFTER_DRAIN) { E(acc, cur, wr, wc, fr, fq); S.done(cur); }
        if (!has_next) break;
#pragma unroll
        for (int a = 0; a < 2; ++a)
#pragma unroll
            for (int b = 0; b < 2; ++b)
#pragma unroll
                for (int m = 0; m < 4; ++m)
#pragma unroll
                    for (int n = 0; n < 2; ++n) acc[a][b][m][n] = (f32x4){0.f, 0.f, 0.f, 0.f};
        cur = nxt; cA = nA; cB = nB; ++ui;
        if constexpr (ALIGN_EPI) { if (wr == 1) PG8_BAR; }
    }
    PG8_WAIT_V(0);
    if constexpr (!ALIGN_EPI) { if (wr == 0) PG8_BAR; }
    PG8_BAR;
    if constexpr (Epi::AFTER_DRAIN) { E.fused(acc, cur, wr, wc, fr, fq, lds, wid, lane); S.done(cur); }
#undef PG8_SA
#undef PG8_SB
#undef PG8_STAGE
#undef PG8_LDA
#undef PG8_LDB
#undef PG8_MMA
#undef PG8_WAIT_V
#undef PG8_WAIT_L
#undef PG8_BAR
#undef PG8_SCHED
}
}


namespace cg = cooperative_groups;
using pg8::bf16x8; using pg8::f32x4; using pg8::u32x4; using pg8::Unit;
typedef float f32x2_ __attribute__((ext_vector_type(2)));
typedef __bf16 bf16x2_ __attribute__((ext_vector_type(2)));
__device__ __forceinline__ unsigned cvt_pk_bf16(float lo, float hi) { f32x2_ v = {lo, hi}; bf16x2_ b = __builtin_convertvector(v, bf16x2_); return __builtin_bit_cast(unsigned, b); }
typedef unsigned short u16;
typedef unsigned u32x2 __attribute__((ext_vector_type(2)));
typedef short s16x4 __attribute__((ext_vector_type(4)));
#define LAS PG8_LAS

#ifndef ONLY_PH
#define ONLY_PH -1
#endif
#define PHON(x) (ONLY_PH < 0 || ONLY_PH == (x))
#ifndef SCANV
#define SCANV 3
#endif
#ifndef MAXPH
#define MAXPH 10
#endif
#ifndef PER_PHASE
#define PER_PHASE 0
#endif

constexpr int T_TOK = 12288, NPROMPT = 8192, DFF = 5504, NINP = 8448, NUP = 11008, NPH = 10;
constexpr float ALPHA = 1.189207115002721f;
constexpr size_t SZQ = (size_t)T_TOK * 1024;
constexpr size_t WS_CTR = 0, WS_MOD = 256, WS_CS = WS_MOD + 3 * 12288 * 4, WS_GATES = WS_CS + 32768, WS_WIN = WS_GATES + (size_t)T_TOK * 16 * 4,
                 WS_WOUT = WS_WIN + (size_t)NINP * 2048 * 2, WS_WUP = WS_WOUT + (size_t)2048 * 2048 * 2, WS_WDN = WS_WUP + (size_t)NUP * 2048 * 2,
                 WS_H = WS_WDN + (size_t)2048 * DFF * 2, WS_QKV = WS_H + (size_t)T_TOK * 2048 * 2, WS_G = WS_QKV + 6 * SZQ * 2, WS_END = WS_G + 2 * SZQ * 2,
                 WS_ACT = WS_QKV;
constexpr size_t OUT_RET = (size_t)T_TOK * 2048, OUT_C = OUT_RET + 16777216, OUT_N = OUT_C + 16777216, OUT_M = OUT_N + 65536;
constexpr int LDS_X = pg8::STAGE_BYTES;
constexpr int KSTR = 528, VSTR = 144, SSTR = 176;
constexpr int L_KS = 0, L_VS = L_KS + 128 * KSTR, L_VW = L_VS + 128 * VSTR, L_SS = L_VW + 128 * VSTR, L_AJ = L_SS + 256 * SSTR, L_MI = L_AJ + 512, L_SP = L_MI + 512,
              L_EM = L_SP + 512, L_WK = L_EM + 512, L_IT = L_WK + 512, LDS_BYTES = L_IT + 64;
static_assert(LDS_BYTES <= 160 * 1024 && LDS_X + 6 * 256 * 4 <= LDS_BYTES, "LDS budget");

struct Params { const float* in[24]; float* out; unsigned char* ws; int ph_lo, ph_hi; };

__device__ __forceinline__ float bf2f(unsigned b) { return __uint_as_float(b << 16); }
__device__ __forceinline__ u16 f2bf(float f) { unsigned u = __float_as_uint(f); u += 0x7FFFu + ((u >> 16) & 1u); return (u16)(u >> 16); }
__device__ __forceinline__ float wave_sum(float v) {
#pragma unroll
    for (int o = 32; o >= 1; o >>= 1) v += __shfl_xor(v, o);
    return v; }
__device__ __forceinline__ float silu_f(float x) { return x / (1.f + __expf(-x)); }
__device__ __forceinline__ float sigm_f(float x) { return 1.f / (1.f + __expf(-x)); }
__device__ __forceinline__ float logsig_f(float x) { return fminf(x, 0.f) - log1pf(expf(-fabsf(x))); }
__device__ __forceinline__ const float* xrow(const Params& P, int t) { return t < NPROMPT ? P.in[0] + (size_t)t * 2048 : P.in[1] + (size_t)(t - NPROMPT) * 2048; }
__device__ __forceinline__ int modvec(int t) { return t < NPROMPT ? 0 : 1 + ((t - NPROMPT) >> 11); }
#define LDS_SYNC() do { asm volatile("s_waitcnt lgkmcnt(0)" ::: "memory"); __builtin_amdgcn_s_barrier(); asm volatile("" ::: "memory"); } while (0)

__device__ __forceinline__ void phase0(const Params& P, LAS unsigned char* lds) {
    const int tid = threadIdx.x, nb = gridDim.x, b = blockIdx.x;
    LAS float* sv = (LAS float*)lds;
    LAS float* red = (LAS float*)(lds + 24576);
    const float* c_in = P.in[6]; const float* c_ctx = P.in[7]; const float* w_mod = P.in[8]; const float* b_mod = P.in[9];
    float* mod = (float*)(P.ws + WS_MOD);
    for (int i = tid; i < 3 * 2048; i += 512) { const int v = i >> 11, k = i & 2047; const float c = v == 0 ? c_ctx[k] : c_in[(v - 1) * 2048 + k]; sv[i] = c / (1.f + expf(-c)); }
    __syncthreads();
    for (int slab = b; slab < 256; slab += nb) {
        const int cq = tid % 12, kl = tid / 12;
        float a0[4] = {0.f, 0.f, 0.f, 0.f}, a1[4] = {0.f, 0.f, 0.f, 0.f}, a2[4] = {0.f, 0.f, 0.f, 0.f};
        if (tid < 504) {
            const float* wp = w_mod + (size_t)48 * slab + 4 * cq;
#pragma unroll 7
            for (int k = kl; k < 2048; k += 42) {
                const f32x4 w = __builtin_nontemporal_load((const f32x4*)(wp + (size_t)k * 12288)); const float s0 = sv[k], s1 = sv[2048 + k], s2 = sv[4096 + k];
#pragma unroll
                for (int e = 0; e < 4; ++e) { a0[e] += s0 * w[e]; a1[e] += s1 * w[e]; a2[e] += s2 * w[e]; }
            }
#pragma unroll
            for (int e = 0; e < 4; ++e) { red[(kl * 3 + 0) * 48 + 4 * cq + e] = a0[e]; red[(kl * 3 + 1) * 48 + 4 * cq + e] = a1[e]; red[(kl * 3 + 2) * 48 + 4 * cq + e] = a2[e]; }
        }
        __syncthreads();
        if (tid < 144) { const int v = tid / 48, col = tid % 48; float s = 0.f; for (int k2 = 0; k2 < 42; ++k2) s += red[(k2 * 3 + v) * 48 + col]; mod[v * 12288 + 48 * slab + col] = s + b_mod[48 * slab + col]; }
        __syncthreads();
    }
    float2* cs = (float2*)(P.ws + WS_CS);
    for (int i = b * 512 + tid; i < 4096; i += nb * 512) { const int pos = i >> 6, j = i & 63; const float inv = exp2f(-(float)j * (13.287712379549449f / 64.f)); const float ang = (float)pos * inv;
        cs[i] = make_float2(__cosf(ang), __sinf(ang)); }
    LAS u16* tl = (LAS u16*)lds;
    constexpr int n_in = 132 * 16, n_out = 32 * 16, n_up = 172 * 16, n_dn = 32 * 43, n_all = n_in + n_out + n_up + n_dn;
    for (int tix = b; tix < n_all; tix += nb) {
        const float* W; u16* Bt; int K, Nsrc, nbk, kb, src, nvalid = 64;
        if (tix < n_in) { W = P.in[10]; Bt = (u16*)(P.ws + WS_WIN); K = 2048; Nsrc = 8208; nbk = tix >> 4; kb = tix & 15;
            const int n0 = nbk * 64, pn = n0 >> 8, p = n0 & 255;
            if (pn < 8) { const int bj = p >> 7, q = p & 127; src = pn * 256 + (q < 64 ? 64 * bj : 128 + 64 * bj); }
            else if (pn < 32) src = n0;
            else { src = 8192; nvalid = (p == 0) ? 16 : 0; } }
        else if (tix < n_in + n_out) { const int r = tix - n_in; W = P.in[16]; Bt = (u16*)(P.ws + WS_WOUT); K = 2048; Nsrc = 2048; nbk = r >> 4; kb = r & 15; src = nbk * 64; }
        else if (tix < n_in + n_out + n_up) { const int r = tix - n_in - n_out; W = P.in[19]; Bt = (u16*)(P.ws + WS_WUP); K = 2048; Nsrc = NUP; nbk = r >> 4; kb = r & 15;
            const int n0 = nbk * 64, pn = n0 >> 8, p = n0 & 255; src = p < 128 ? 128 * pn + p : DFF + 128 * pn + (p - 128); }
        else { const int r = tix - n_in - n_out - n_up; W = P.in[21]; Bt = (u16*)(P.ws + WS_WDN); K = DFF; Nsrc = 2048; nbk = r / 43; kb = r % 43; src = nbk * 64; }
        const int k0 = kb * 128, n0 = nbk * 64;
#pragma unroll
        for (int x = 0; x < 4; ++x) { const int idx = tid + 512 * x, kk = idx >> 4, c4 = idx & 15;
            f32x4 w = (f32x4){0.f, 0.f, 0.f, 0.f};
            if (4 * c4 < nvalid) w = __builtin_nontemporal_load((const f32x4*)(W + (size_t)(k0 + kk) * Nsrc + src + 4 * c4));
#pragma unroll
            for (int e = 0; e < 4; ++e) tl[(4 * c4 + e) * 132 + kk] = f2bf(w[e]); }
        __syncthreads();
#pragma unroll
        for (int x = 0; x < 2; ++x) { const int idx = tid + 512 * x, n = idx >> 4, ch = idx & 15;
            const u32x2 lo = *(const LAS u32x2*)(tl + n * 132 + 8 * ch), hi = *(const LAS u32x2*)(tl + n * 132 + 8 * ch + 4);
            *(u32x4*)(Bt + (size_t)(n0 + n) * K + k0 + 8 * ch) = (u32x4){lo.x, lo.y, hi.x, hi.y}; }
        __syncthreads();
    }
}

__device__ __forceinline__ void ln_stats(const f32x4 (&v)[8], float& mu, float& rstd) {
    float s = 0.f;
#pragma unroll
    for (int i = 0; i < 8; ++i) s += (v[i][0] + v[i][1]) + (v[i][2] + v[i][3]);
    s = wave_sum(s); mu = s * (1.f / 2048.f);
    float q = 0.f;
#pragma unroll
    for (int i = 0; i < 8; ++i) { const f32x4 d = v[i] - mu; q += (d[0] * d[0] + d[1] * d[1]) + (d[2] * d[2] + d[3] * d[3]); }
    q = wave_sum(q); rstd = rsqrtf(q * (1.f / 2048.f) + 1e-6f);
}
__device__ __forceinline__ void phase1(const Params& P) {
    const int lane = threadIdx.x & 63, gw = blockIdx.x * 8 + (threadIdx.x >> 6), nw = gridDim.x * 8;
    const float* mod = (const float*)(P.ws + WS_MOD); u16* H = (u16*)(P.ws + WS_H);
    for (int t = gw; t < T_TOK; t += nw) {
        const f32x4* xr = (const f32x4*)xrow(P, t); f32x4 v[8];
#pragma unroll
        for (int i = 0; i < 8; ++i) v[i] = __builtin_nontemporal_load(xr + lane + 64 * i);
        float mu, rstd; ln_stats(v, mu, rstd);
        const float* md = mod + modvec(t) * 12288;
#pragma unroll
        for (int i = 0; i < 8; ++i) { const int col = 4 * (lane + 64 * i); const f32x4 sh = *(const f32x4*)(md + col), sc = *(const f32x4*)(md + 2048 + col);
            const f32x4 h = (v[i] - mu) * rstd * (sc + 1.f) + sh;
            *(u32x2*)(H + (size_t)t * 2048 + col) = (u32x2){cvt_pk_bf16(h[0], h[1]), cvt_pk_bf16(h[2], h[3])}; }
    }
}
__device__ __forceinline__ void phase4(const Params& P) {
    const int lane = threadIdx.x & 63, gw = blockIdx.x * 8 + (threadIdx.x >> 6), nw = gridDim.x * 8;
    const u16* O0 = (const u16*)P.out; const u16* O1 = O0 + (size_t)T_TOK * 2048; const u16* G = (const u16*)(P.ws + WS_G); u16* H = (u16*)(P.ws + WS_H);
    for (int t = gw; t < T_TOK; t += nw) {
#pragma unroll
        for (int grp = 0; grp < 8; ++grp) {
            const int col = grp * 256 + lane * 4;
            const u32x2 a = *(const u32x2*)(O0 + (size_t)t * 2048 + col), b = *(const u32x2*)(O1 + (size_t)t * 2048 + col);
            f32x4 s; s[0] = bf2f(a.x & 0xffffu) + bf2f(b.x & 0xffffu); s[1] = bf2f(a.x >> 16) + bf2f(b.x >> 16); s[2] = bf2f(a.y & 0xffffu) + bf2f(b.y & 0xffffu); s[3] = bf2f(a.y >> 16) + bf2f(b.y >> 16);
            const float mu = wave_sum((s[0] + s[1]) + (s[2] + s[3])) * (1.f / 256.f);
            const f32x4 d = s - mu; const float rstd = rsqrtf(wave_sum((d[0] * d[0] + d[1] * d[1]) + (d[2] * d[2] + d[3] * d[3])) * (1.f / 256.f) + 1e-6f);
            const f32x4 gn = grp < 4 ? *(const f32x4*)(P.in[14] + grp * 256 + lane * 4) : *(const f32x4*)(P.in[15] + (grp - 4) * 256 + lane * 4);
            const u32x2 gt = *(const u32x2*)(G + (grp < 4 ? 0 : SZQ) + (size_t)t * 1024 + (grp & 3) * 256 + lane * 4);
            const f32x4 o = d * rstd * gn * (f32x4){bf2f(gt.x & 0xffffu), bf2f(gt.x >> 16), bf2f(gt.y & 0xffffu), bf2f(gt.y >> 16)};
            *(u32x2*)(H + (size_t)t * 2048 + col) = (u32x2){cvt_pk_bf16(o[0], o[1]), cvt_pk_bf16(o[2], o[3])};
        }
    }
}
__device__ __forceinline__ void phase6(const Params& P) {
    const int lane = threadIdx.x & 63, gw = blockIdx.x * 8 + (threadIdx.x >> 6), nw = gridDim.x * 8;
    const float* mod = (const float*)(P.ws + WS_MOD); u16* H = (u16*)(P.ws + WS_H);
    for (int t = gw; t < T_TOK; t += nw) {
        f32x4* yr = (f32x4*)(P.out + (size_t)t * 2048); f32x4 v[8];
#pragma unroll
        for (int i = 0; i < 8; ++i) v[i] = yr[lane + 64 * i];
        float mu, rstd; ln_stats(v, mu, rstd);
#pragma unroll
        for (int i = 0; i < 8; ++i) { const int col = 4 * (lane + 64 * i); v[i] = (v[i] - mu) * rstd * *(const f32x4*)(P.in[17] + col) + *(const f32x4*)(P.in[18] + col); yr[lane + 64 * i] = v[i]; }
        ln_stats(v, mu, rstd);
        const float* md = mod + modvec(t) * 12288;
#pragma unroll
        for (int i = 0; i < 8; ++i) { const int col = 4 * (lane + 64 * i); const f32x4 sh = *(const f32x4*)(md + 6144 + col), sc = *(const f32x4*)(md + 8192 + col);
            const f32x4 h = (v[i] - mu) * rstd * (sc + 1.f) + sh;
            *(u32x2*)(H + (size_t)t * 2048 + col) = (u32x2){cvt_pk_bf16(h[0], h[1]), cvt_pk_bf16(h[2], h[3])}; }
    }
}
__device__ __forceinline__ void phase9(const Params& P) {
    const int lane = threadIdx.x & 63, gw = blockIdx.x * 8 + (threadIdx.x >> 6), nw = gridDim.x * 8;
    for (int t = gw; t < T_TOK; t += nw) {
        f32x4* yr = (f32x4*)(P.out + (size_t)t * 2048); f32x4 v[8];
#pragma unroll
        for (int i = 0; i < 8; ++i) v[i] = yr[lane + 64 * i];
        float mu, rstd; ln_stats(v, mu, rstd);
#pragma unroll
        for (int i = 0; i < 8; ++i) { const int col = 4 * (lane + 64 * i); yr[lane + 64 * i] = (v[i] - mu) * rstd * *(const f32x4*)(P.in[22] + col) + *(const f32x4*)(P.in[23] + col); }
    }
}

__device__ __forceinline__ void conv4(const f32x4 (&v)[4], const f32x4 bprev, const f32x4 bnext, const f32x4 w0, const f32x4 w1, const f32x4 w2, int lane, int fr, f32x4 (&y)[4]) {
    const int lp = (lane & 48) | ((fr - 1) & 15), ln = (lane & 48) | ((fr + 1) & 15);
#pragma unroll
    for (int m = 0; m < 4; ++m)
#pragma unroll
        for (int e = 0; e < 4; ++e) {
            const float sp_ = (fr == 15) ? (m > 0 ? v[m > 0 ? m - 1 : 0][e] : 0.f) : v[m][e]; float p = __shfl(sp_, lp); if (m == 0 && fr == 0) p = bprev[e];
            const float sn_ = (fr == 0) ? (m < 3 ? v[m < 3 ? m + 1 : 3][e] : 0.f) : v[m][e]; float q = __shfl(sn_, ln); if (m == 3 && fr == 15) q = bnext[e];
            y[m][e] = w0[e] * p + w1[e] * v[m][e] + w2[e] * q;
        }
}
struct EpiRes {
    static constexpr bool PERM = false, AFTER_DRAIN = false;
    const float* xp; const float* xs; float* out; const float* mod; int goff;
    __device__ __forceinline__ void operator()(const f32x4 (&acc)[2][2][4][2], const Unit& u, int wr, int wc, int fr, int fq) const {
        const int v = u.pm < 32 ? 0 : 1 + ((u.pm - 32) >> 3), col0 = u.pn * 256 + wc * 32 + 4 * fq;
        const float* gv = mod + v * 12288 + goff + col0;
        f32x4 g[2][2];
#pragma unroll
        for (int bj = 0; bj < 2; ++bj)
#pragma unroll
            for (int n = 0; n < 2; ++n) g[bj][n] = *(const f32x4*)(gv + bj * 128 + n * 16);
#pragma unroll
        for (int ai = 0; ai < 2; ++ai)
#pragma unroll
            for (int m = 0; m < 4; ++m) { const int r = u.pm * 256 + ai * 128 + wr * 64 + m * 16 + fr;
                const float* bp = (r < NPROMPT ? xp + (size_t)r * 2048 : xs + (size_t)(r - NPROMPT) * 2048) + col0; float* op = out + (size_t)r * 2048 + col0;
#pragma unroll
                for (int bj = 0; bj < 2; ++bj)
#pragma unroll
                    for (int n = 0; n < 2; ++n) { const f32x4 bs = *(const f32x4*)(bp + bj * 128 + n * 16); *(f32x4*)(op + bj * 128 + n * 16) = bs * ALPHA + g[bj][n] * acc[ai][bj][m][n]; }
                asm volatile("" ::: "memory"); }
    }
};
struct EpiUp {
    static constexpr bool PERM = true, AFTER_DRAIN = false;
    u16* act; const float* cw; LAS float* X;
    __device__ __forceinline__ void operator()(const f32x4 (&acc)[2][2][4][2], const Unit& u, int wr, int wc, int fr, int fq) const {
        const int lane = threadIdx.x & 63, lc = wc * 32 + 8 * fq; const bool prompt = u.pm < 32;
#pragma unroll
        for (int ai = 0; ai < 2; ++ai) { const int grp = 2 * ai + wr;
            if (fr == 15 && grp < 3) { *(LAS f32x4*)(X + (2 * grp) * 256 + lc) = acc[ai][0][3][0]; *(LAS f32x4*)(X + (2 * grp) * 256 + lc + 4) = acc[ai][0][3][1]; }
            if (fr == 0 && grp > 0) { *(LAS f32x4*)(X + (2 * grp - 1) * 256 + lc) = acc[ai][0][0][0]; *(LAS f32x4*)(X + (2 * grp - 1) * 256 + lc + 4) = acc[ai][0][0][1]; } }
        LDS_SYNC();
        const int j0 = u.pn * 128 + lc;
#pragma unroll
        for (int ai = 0; ai < 2; ++ai) { const int grp = 2 * ai + wr; f32x4 res[4][2];
#pragma unroll
            for (int n = 0; n < 2; ++n) {
                f32x4 bprev = (f32x4){0.f, 0.f, 0.f, 0.f}, bnext = bprev;
                if (prompt) { if (grp > 0) bprev = *(const LAS f32x4*)(X + (2 * grp - 2) * 256 + lc + 4 * n); if (grp < 3) bnext = *(const LAS f32x4*)(X + (2 * grp + 1) * 256 + lc + 4 * n); }
                const f32x4 w0 = *(const f32x4*)(cw + j0 + 4 * n), w1 = *(const f32x4*)(cw + DFF + j0 + 4 * n), w2 = *(const f32x4*)(cw + 2 * DFF + j0 + 4 * n);
                f32x4 v[4], y[4];
#pragma unroll
                for (int m = 0; m < 4; ++m) v[m] = acc[ai][0][m][n];
                conv4(v, bprev, bnext, w0, w1, w2, lane, fr, y);
#pragma unroll
                for (int m = 0; m < 4; ++m)
#pragma unroll
                    for (int e = 0; e < 4; ++e) res[m][n][e] = silu_f(y[m][e]) * acc[ai][1][m][n][e];
            }
#pragma unroll
            for (int m = 0; m < 4; ++m) { const int r = u.pm * 256 + ai * 128 + wr * 64 + m * 16 + fr;
                *(u32x4*)(act + (size_t)r * DFF + j0) = (u32x4){pg8::cvt_pk_bf16(res[m][0][0], res[m][0][1]), pg8::cvt_pk_bf16(res[m][0][2], res[m][0][3]), pg8::cvt_pk_bf16(res[m][1][0], res[m][1][1]), pg8::cvt_pk_bf16(res[m][1][2], res[m][1][3])}; }
        }
    }
};
struct EpiIn {
    static constexpr bool PERM = true, AFTER_DRAIN = false;
    u16* qkv; u16* gbuf; float* gates; const float* b_gate; const float* cqk; const float2* cs; LAS float* X;
    __device__ __forceinline__ void operator()(const f32x4 (&acc)[2][2][4][2], const Unit& u, int wr, int wc, int fr, int fq) const {
        const int lane = threadIdx.x & 63, cls = u.pn >> 2, hh = u.pn & 3, q0 = wc * 32 + 8 * fq; const bool prompt = u.pm < 32;
        const int rbase = u.pm * 256 + wr * 64 + fr;
        if (cls == 8) {
            if (wc == 0 && fq < 2) {
#pragma unroll
                for (int ai = 0; ai < 2; ++ai)
#pragma unroll
                    for (int m = 0; m < 4; ++m) { const int r = rbase + ai * 128 + m * 16;
#pragma unroll
                        for (int n = 0; n < 2; ++n) *(f32x4*)(gates + (size_t)r * 16 + 8 * fq + 4 * n) = acc[ai][0][m][n] + *(const f32x4*)(b_gate + 8 * fq + 4 * n); } }
        } else if (cls == 4 || cls == 5) {
#pragma unroll
            for (int ai = 0; ai < 2; ++ai) { const int grp = 2 * ai + wr;
#pragma unroll
                for (int bj = 0; bj < 2; ++bj)
#pragma unroll
                    for (int n = 0; n < 2; ++n) { const int xc = bj * 128 + q0 + 4 * n;
                        if (fr == 15 && grp < 3) *(LAS f32x4*)(X + (2 * grp) * 256 + xc) = acc[ai][bj][3][n];
                        if (fr == 0 && grp > 0) *(LAS f32x4*)(X + (2 * grp - 1) * 256 + xc) = acc[ai][bj][0][n]; } }
            LDS_SYNC();
            u16* ob = qkv + (cls == 4 ? 3 : 4) * SZQ; const float scl = cls == 4 ? 1.f : 0.0625f; const int chb = (cls == 4 ? 0 : 1024) + hh * 256;
#pragma unroll
            for (int ai = 0; ai < 2; ++ai) { const int grp = 2 * ai + wr;
#pragma unroll
                for (int bj = 0; bj < 2; ++bj) { f32x4 res[4][2];
#pragma unroll
                    for (int n = 0; n < 2; ++n) { const int xc = bj * 128 + q0 + 4 * n;
                        f32x4 bprev = (f32x4){0.f, 0.f, 0.f, 0.f}, bnext = bprev;
                        if (prompt) { if (grp > 0) bprev = *(const LAS f32x4*)(X + (2 * grp - 2) * 256 + xc); if (grp < 3) bnext = *(const LAS f32x4*)(X + (2 * grp + 1) * 256 + xc); }
                        const f32x4 w0 = *(const f32x4*)(cqk + chb + xc), w1 = *(const f32x4*)(cqk + 2048 + chb + xc), w2 = *(const f32x4*)(cqk + 4096 + chb + xc);
                        f32x4 v[4], y[4];
#pragma unroll
                        for (int m = 0; m < 4; ++m) v[m] = acc[ai][bj][m][n];
                        conv4(v, bprev, bnext, w0, w1, w2, lane, fr, y);
#pragma unroll
                        for (int m = 0; m < 4; ++m)
#pragma unroll
                            for (int e = 0; e < 4; ++e) res[m][n][e] = silu_f(y[m][e]) * scl; }
#pragma unroll
                    for (int m = 0; m < 4; ++m) { const int r = rbase + ai * 128 + m * 16;
                        *(u32x4*)(ob + (size_t)r * 1024 + hh * 256 + bj * 128 + q0) = (u32x4){pg8::cvt_pk_bf16(res[m][0][0], res[m][0][1]), pg8::cvt_pk_bf16(res[m][0][2], res[m][0][3]), pg8::cvt_pk_bf16(res[m][1][0], res[m][1][1]), pg8::cvt_pk_bf16(res[m][1][2], res[m][1][3])}; }
                } }
        } else if (cls < 2) {
            u16* ob = qkv + cls * SZQ; const float scl = cls == 0 ? 1.f : 0.0625f;
            const int d0 = (wc < 2) ? q0 : 128 + (q0 - 64), jf0 = q0 & 63, seg = (u.pm - 32) & 7;
#pragma unroll
            for (int ai = 0; ai < 2; ++ai)
#pragma unroll
                for (int m = 0; m < 4; ++m) { const int r = rbase + ai * 128 + m * 16, rl = ai * 128 + wr * 64 + m * 16 + fr;
                    f32x4 o1[2], o2[2];
#pragma unroll
                    for (int n = 0; n < 2; ++n) { const f32x4 x1 = acc[ai][0][m][n] * scl, x2 = acc[ai][1][m][n] * scl;
                        if (!prompt) { const int pos = (wc < 2) ? seg * 4 + (rl >> 6) : (rl & 63); const float* cp = (const float*)(cs + pos * 64 + jf0 + 4 * n);
                            const f32x4 ca = *(const f32x4*)cp, cb = *(const f32x4*)(cp + 4);
                            const f32x4 co = (f32x4){ca[0], ca[2], cb[0], cb[2]}, si = (f32x4){ca[1], ca[3], cb[1], cb[3]};
                            o1[n] = x1 * co - x2 * si; o2[n] = x1 * si + x2 * co; }
                        else { o1[n] = x1; o2[n] = x2; } }
                    u16* rp = ob + (size_t)r * 1024 + hh * 256 + d0;
                    *(u32x4*)rp = (u32x4){pg8::cvt_pk_bf16(o1[0][0], o1[0][1]), pg8::cvt_pk_bf16(o1[0][2], o1[0][3]), pg8::cvt_pk_bf16(o1[1][0], o1[1][1]), pg8::cvt_pk_bf16(o1[1][2], o1[1][3])};
                    *(u32x4*)(rp + 64) = (u32x4){pg8::cvt_pk_bf16(o2[0][0], o2[0][1]), pg8::cvt_pk_bf16(o2[0][2], o2[0][3]), pg8::cvt_pk_bf16(o2[1][0], o2[1][1]), pg8::cvt_pk_bf16(o2[1][2], o2[1][3])}; }
        } else {
            u16* ob = cls == 2 ? qkv + 2 * SZQ : cls == 6 ? qkv + 5 * SZQ : cls == 3 ? gbuf : gbuf + SZQ;
#pragma unroll
            for (int ai = 0; ai < 2; ++ai)
#pragma unroll
                for (int m = 0; m < 4; ++m) { const int r = rbase + ai * 128 + m * 16;
#pragma unroll
                    for (int bj = 0; bj < 2; ++bj) { f32x4 a = acc[ai][bj][m][0], b = acc[ai][bj][m][1];
                        if (cls == 3) {
#pragma unroll
                            for (int e = 0; e < 4; ++e) { a[e] = silu_f(a[e]); b[e] = silu_f(b[e]); } }
                        if (cls == 7) {
#pragma unroll
                            for (int e = 0; e < 4; ++e) { a[e] = sigm_f(a[e]); b[e] = sigm_f(b[e]); } }
                        *(u32x4*)(ob + (size_t)r * 1024 + hh * 256 + bj * 128 + q0) = (u32x4){pg8::cvt_pk_bf16(a[0], a[1]), pg8::cvt_pk_bf16(a[2], a[3]), pg8::cvt_pk_bf16(b[0], b[1]), pg8::cvt_pk_bf16(b[2], b[3])}; } }
        }
    }
};

__device__ __forceinline__ void tr_issue(s16x4& r, unsigned addr) { asm volatile("ds_read_b64_tr_b16 %0, %1" : "=v"(r) : "v"(addr) : "memory"); }

static_assert(SSTR == 176 && VSTR == 144 && KSTR == 528, "literal offsets in the asm batches");
__device__ __forceinline__ void tr_batch_s(unsigned base, s16x4 (&a)[5], s16x4 (&b)[5]) {
    asm volatile("ds_read_b64_tr_b16 %0, %10\n\tds_read_b64_tr_b16 %1, %10 offset:32\n\tds_read_b64_tr_b16 %2, %10 offset:64\n\tds_read_b64_tr_b16 %3, %10 offset:96\n\tds_read_b64_tr_b16 %4, %10 offset:128\n\t"
                 "ds_read_b64_tr_b16 %5, %10 offset:704\n\tds_read_b64_tr_b16 %6, %10 offset:736\n\tds_read_b64_tr_b16 %7, %10 offset:768\n\tds_read_b64_tr_b16 %8, %10 offset:800\n\tds_read_b64_tr_b16 %9, %10 offset:832\n\t"
                 "s_waitcnt lgkmcnt(0)"
                 : "=&v"(a[0]), "=&v"(a[1]), "=&v"(a[2]), "=&v"(a[3]), "=&v"(a[4]), "=&v"(b[0]), "=&v"(b[1]), "=&v"(b[2]), "=&v"(b[3]), "=&v"(b[4]) : "v"(base) : "memory");
}
__device__ __forceinline__ void tr_batch_v(unsigned base, s16x4 (&a)[4], s16x4 (&b)[4]) {
    asm volatile("ds_read_b64_tr_b16 %0, %8\n\tds_read_b64_tr_b16 %1, %8 offset:32\n\tds_read_b64_tr_b16 %2, %8 offset:64\n\tds_read_b64_tr_b16 %3, %8 offset:96\n\t"
                 "ds_read_b64_tr_b16 %4, %8 offset:2304\n\tds_read_b64_tr_b16 %5, %8 offset:2336\n\tds_read_b64_tr_b16 %6, %8 offset:2368\n\tds_read_b64_tr_b16 %7, %8 offset:2400\n\t"
                 "s_waitcnt lgkmcnt(0)"
                 : "=&v"(a[0]), "=&v"(a[1]), "=&v"(a[2]), "=&v"(a[3]), "=&v"(b[0]), "=&v"(b[1]), "=&v"(b[2]), "=&v"(b[3]) : "v"(base) : "memory");
}
__device__ __forceinline__ void tr_batch_kv(unsigned kb, unsigned vb, s16x4 (&k)[4], s16x4 (&a)[4], s16x4 (&b)[4]) {
    asm volatile("ds_read_b64_tr_b16 %0, %12\n\tds_read_b64_tr_b16 %1, %12 offset:2112\n\tds_read_b64_tr_b16 %2, %12 offset:32\n\tds_read_b64_tr_b16 %3, %12 offset:2144\n\t"
                 "ds_read_b64_tr_b16 %4, %13\n\tds_read_b64_tr_b16 %5, %13 offset:32\n\tds_read_b64_tr_b16 %6, %13 offset:64\n\tds_read_b64_tr_b16 %7, %13 offset:96\n\t"
                 "ds_read_b64_tr_b16 %8, %13 offset:576\n\tds_read_b64_tr_b16 %9, %13 offset:608\n\tds_read_b64_tr_b16 %10, %13 offset:640\n\tds_read_b64_tr_b16 %11, %13 offset:672\n\t"
                 "s_waitcnt lgkmcnt(0)"
                 : "=&v"(k[0]), "=&v"(k[1]), "=&v"(k[2]), "=&v"(k[3]), "=&v"(a[0]), "=&v"(a[1]), "=&v"(a[2]), "=&v"(a[3]), "=&v"(b[0]), "=&v"(b[1]), "=&v"(b[2]), "=&v"(b[3]) : "v"(kb), "v"(vb) : "memory");
}
__device__ __forceinline__ bf16x8 cat8(const s16x4 a, const s16x4 b) { return (bf16x8){a[0], a[1], a[2], a[3], b[0], b[1], b[2], b[3]}; }
#define MFMA16(a, b, c) __builtin_amdgcn_mfma_f32_16x16x32_bf16(a, b, c, 0, 0, 0)

__device__ __forceinline__ void scan_item(const Params& P, LAS unsigned char* lds, const int MLSTM, int sample, int b, int dir, int h, int vb) {
    constexpr int NV = 5;
    const int tid = threadIdx.x, w = __builtin_amdgcn_readfirstlane(tid >> 6), lane = tid & 63, i16 = lane & 15, g = lane >> 4, q = (lane & 15) >> 2, p = lane & 3;
    const unsigned lbase = (unsigned)(uintptr_t)lds;
    const int L = sample ? 2048 : 256, nsteps = L >> 7, tok0 = sample ? NPROMPT + b * 2048 : b * 256;
    const u16* QB = (const u16*)(P.ws + WS_QKV) + (MLSTM ? 3 : 0) * SZQ + h * 256; const u16* KB = QB + SZQ; const u16* VB = QB + 2 * SZQ + vb * 64;
    const float* gates = (const float*)(P.ws + WS_GATES);
    u16* OB = (u16*)P.out + (size_t)dir * T_TOK * 2048 + (MLSTM ? 1024 : 0) + h * 256 + vb * 64;
    LAS float* AJ = (LAS float*)(lds + L_AJ); LAS float* MI = (LAS float*)(lds + L_MI); LAS float* SPI = (LAS float*)(lds + L_SP); LAS float* EMT = (LAS float*)(lds + L_EM); LAS float* WKJ = (LAS float*)(lds + L_WK);
    const int sidx = (b * 2 + dir) * 4 + h;
    f32x4 accS[NV][2];
#pragma unroll
    for (int vt = 0; vt < NV; ++vt)
#pragma unroll
        for (int kk = 0; kk < 2; ++kk) accS[vt][kk] = (f32x4){0.f, 0.f, 0.f, 0.f};
    float m_run = 0.f, lg = 0.f;
    if (sample) {
        const float* S0 = (MLSTM ? P.in[3] : P.in[2]) + (size_t)sidx * 65536 + vb * 64;
#pragma unroll
        for (int vt = 0; vt < 4; ++vt)
#pragma unroll
            for (int kk = 0; kk < 2; ++kk) accS[vt][kk] = *(const f32x4*)(S0 + (size_t)(32 * w + 16 * kk + i16) * 256 + 16 * vt + 4 * g);
        if (MLSTM) {
#pragma unroll
            for (int kk = 0; kk < 2; ++kk) accS[NV - 1][kk][0] = g == 0 ? P.in[4][sidx * 256 + 32 * w + 16 * kk + i16] : 0.f;
            m_run = P.in[5][sidx]; }
    }
    float wk0 = 0.f, wk1 = 0.f, sc = 0.f;
    if (!MLSTM) {
        lg = logsig_f(P.in[13][dir * 4 + h]);
        wk0 = expf(lg * (float)(127 - 2 * lane)); wk1 = expf(lg * (float)(126 - 2 * lane)); sc = expf(lg * 128.f);
        if (w == 0) { WKJ[2 * lane] = wk0; WKJ[2 * lane + 1] = wk1; EMT[2 * lane] = 1.f; EMT[2 * lane + 1] = 1.f; AJ[2 * lane] = -lg * (float)(2 * lane); AJ[2 * lane + 1] = -lg * (float)(2 * lane + 1); MI[2 * lane] = -lg * (float)(2 * lane); MI[2 * lane + 1] = -lg * (float)(2 * lane + 1);
            SPI[2 * lane] = expf(lg * (float)(2 * lane + 1)); SPI[2 * lane + 1] = expf(lg * (float)(2 * lane + 2)); }
    }
#pragma unroll
    for (int vt = 0; vt < NV; ++vt)
#pragma unroll
        for (int kk = 0; kk < 2; ++kk)
            *(LAS u32x2*)(lds + L_SS + (32 * w + 16 * kk + i16) * SSTR + (16 * vt + 4 * g) * 2) = (u32x2){cvt_pk_bf16(accS[vt][kk][0], accS[vt][kk][1]), cvt_pk_bf16(accS[vt][kk][2], accS[vt][kk][3])};

    const int tid0 = tid;
    for (int step = 0; step < nsteps; ++step) {
        const int tb = tok0 + (dir ? L - 128 * (step + 1) : 128 * step);
        int tid = tid0; asm volatile("" : "+v"(tid));
        const int lane = tid & 63, i16 = lane & 15, g = lane >> 4, q = (lane & 15) >> 2, p = lane & 3;
#define TOK(i) (tb + (dir ? 127 - (i) : (i)))
        if (MLSTM) {
            const int t0 = TOK(2 * lane), t1 = TOK(2 * lane + 1);
            const float ig0 = gates[(size_t)t0 * 16 + dir * 8 + h], fg0 = gates[(size_t)t0 * 16 + dir * 8 + 4 + h], ig1 = gates[(size_t)t1 * 16 + dir * 8 + h], fg1 = gates[(size_t)t1 * 16 + dir * 8 + 4 + h];
            const float lf0 = logsig_f(fg0), lf1 = logsig_f(fg1), c1 = lf0 + lf1;
            float inc = c1;
#pragma unroll
            for (int o = 1; o < 64; o <<= 1) { const float t = __shfl_up(inc, o); if (lane >= o) inc += t; }
            const float b0 = inc - c1 + lf0, b1 = inc;
            const float a0 = ig0 - b0, a1 = ig1 - b1, p1 = fmaxf(a0, a1);
            float imx = p1;
#pragma unroll
            for (int o = 1; o < 64; o <<= 1) { const float t = __shfl_up(imx, o); if (lane >= o) imx = fmaxf(imx, t); }
            float emx = __shfl_up(imx, 1); if (lane == 0) emx = -INFINITY;
            const float M0 = fmaxf(m_run, fmaxf(emx, a0)), M1 = fmaxf(m_run, imx);
            const float M127 = __shfl(M1, 63), b127 = __shfl(b1, 63);
            wk0 = expf(a0 - M127); wk1 = expf(a1 - M127); sc = expf(m_run - M127);
            if (w == 0) { AJ[2 * lane] = a0; AJ[2 * lane + 1] = a1; MI[2 * lane] = M0; MI[2 * lane + 1] = M1; SPI[2 * lane] = expf(m_run - M0); SPI[2 * lane + 1] = expf(m_run - M1);
                EMT[2 * lane] = expf(-(b0 + M0)); EMT[2 * lane + 1] = expf(-(b1 + M1)); WKJ[2 * lane] = wk0; WKJ[2 * lane + 1] = wk1; }
            m_run = b127 + M127;
        }
        {
#pragma unroll
            for (int hb = 0; hb < 2; ++hb) { u32x4 kr[4];
#pragma unroll
                for (int x = 0; x < 4; ++x) { const int idx = tid + 512 * (4 * hb + x), row = idx >> 5, ch = idx & 31; kr[x] = *(const u32x4*)(KB + (size_t)TOK(row) * 1024 + ch * 8); }
#pragma unroll
                for (int x = 0; x < 4; ++x) { const int idx = tid + 512 * (4 * hb + x), row = idx >> 5, ch = idx & 31; *(LAS u32x4*)(lds + L_KS + row * KSTR + ch * 16) = kr[x]; }
                asm volatile("" ::: "memory"); }
            u32x4 vr[2];
#pragma unroll
            for (int x = 0; x < 2; ++x) { const int idx = tid + 512 * x, row = idx >> 3, ch = idx & 7; vr[x] = *(const u32x4*)(VB + (size_t)TOK(row) * 1024 + ch * 8); }
#pragma unroll
            for (int x = 0; x < 2; ++x) { const int idx = tid + 512 * x, row = idx >> 3, ch = idx & 7;
                *(LAS u32x4*)(lds + L_VS + row * VSTR + ch * 16) = vr[x];
                const float wa = __shfl(wk0, (row >> 1) & 63), wb = __shfl(wk1, (row >> 1) & 63), wk = (row & 1) ? wb : wa;
                u32x4 o;
#pragma unroll
                for (int e = 0; e < 4; ++e) o[e] = cvt_pk_bf16(bf2f(vr[x][e] & 0xffffu) * wk, bf2f(vr[x][e] >> 16) * wk);
                *(LAS u32x4*)(lds + L_VW + row * VSTR + ch * 16) = o; }
        }
        bf16x8 Qr[8];
        { const u16* qp = QB + (size_t)TOK(16 * w + i16) * 1024 + 8 * g;
#pragma unroll
            for (int ks = 0; ks < 8; ++ks) Qr[ks] = *(const bf16x8*)(qp + 32 * ks); }
        __syncthreads();
        f32x4 ao[4];
#pragma unroll
        for (int vt = 0; vt < 4; ++vt) ao[vt] = (f32x4){0.f, 0.f, 0.f, 0.f};
        float rsum = 0.f;
        const int irow = 16 * w + i16; const float Mi = MI[irow];
        unsigned vbase = lbase + L_VS + (4 * g + q) * VSTR + 8 * p; asm volatile("" : "+v"(vbase));
#pragma unroll
        for (int js = 0; js < 4; ++js) {
            if (2 * js <= w) {
                f32x4 d0 = (f32x4){0.f, 0.f, 0.f, 0.f}, d1 = d0;
                const LAS unsigned char* kp = lds + L_KS + (32 * js + i16) * KSTR + 16 * g;
#pragma unroll
                for (int ks = 0; ks < 8; ++ks) { const bf16x8 k0 = *(const LAS bf16x8*)(kp + 64 * ks), k1 = *(const LAS bf16x8*)(kp + 16 * KSTR + 64 * ks);
                    d0 = MFMA16(k0, Qr[ks], d0); d1 = MFMA16(k1, Qr[ks], d1); if (ks & 1) asm volatile("" ::: "memory"); }
                const f32x4 aj0 = *(const LAS f32x4*)(AJ + 32 * js + 4 * g), aj1 = *(const LAS f32x4*)(AJ + 32 * js + 16 + 4 * g);
                float p0[4], p1[4];
#pragma unroll
                for (int e = 0; e < 4; ++e) { const int j0 = 32 * js + 4 * g + e, j1 = j0 + 16;
                    p0[e] = (j0 <= irow) ? d0[e] * __expf(aj0[e] - Mi) : 0.f; p1[e] = (j1 <= irow) ? d1[e] * __expf(aj1[e] - Mi) : 0.f; rsum += p0[e] + p1[e]; }
                u32x4 pk; pk[0] = cvt_pk_bf16(p0[0], p0[1]); pk[1] = cvt_pk_bf16(p0[2], p0[3]); pk[2] = cvt_pk_bf16(p1[0], p1[1]); pk[3] = cvt_pk_bf16(p1[2], p1[3]);
                const bf16x8 patt = __builtin_bit_cast(bf16x8, pk);
                const unsigned vbs = vbase + (32 * js) * VSTR;
                s16x4 t0[4], t1[4]; tr_batch_v(vbs, t0, t1);
#pragma unroll
                for (int vt = 0; vt < 4; ++vt) ao[vt] = MFMA16(cat8(t0[vt], t1[vt]), patt, ao[vt]);
            }
        }
        f32x4 aqs[NV];
#pragma unroll
        for (int vt = 0; vt < NV; ++vt) aqs[vt] = (f32x4){0.f, 0.f, 0.f, 0.f};
        {
            unsigned sb = lbase + L_SS + (8 * g + q) * SSTR + 8 * p; asm volatile("" : "+v"(sb));
#pragma unroll
            for (int ks = 0; ks < 8; ++ks) {
                s16x4 t0[NV], t1[NV]; tr_batch_s(sb + (32 * ks) * SSTR, t0, t1);
#pragma unroll
                for (int vt = 0; vt < NV; ++vt) aqs[vt] = MFMA16(cat8(t0[vt], t1[vt]), Qr[ks], aqs[vt]);
            }
        }
        {
            const float spi = SPI[irow]; float rden = 1.f;
            if (MLSTM) { rsum += __shfl_xor(rsum, 16); rsum += __shfl_xor(rsum, 32);
                const float qn = __shfl(aqs[NV - 1][0], i16); const float den = rsum + spi * qn; rden = 1.f / fmaxf(fabsf(den), EMT[irow]); }
            u16* op = OB + (size_t)TOK(irow) * 2048 + 4 * g;
#pragma unroll
            for (int vt = 0; vt < 4; ++vt) { const f32x4 o = (ao[vt] + aqs[vt] * spi) * rden; *(u32x2*)(op + 16 * vt) = (u32x2){cvt_pk_bf16(o[0], o[1]), cvt_pk_bf16(o[2], o[3])}; }
        }
#pragma unroll
        for (int vt = 0; vt < NV; ++vt)
#pragma unroll
            for (int kk = 0; kk < 2; ++kk) accS[vt][kk] *= sc;
        {
            unsigned kb_ = lbase + L_KS + (8 * g + q) * KSTR + (32 * w + 4 * p) * 2, vw_ = lbase + L_VW + (8 * g + q) * VSTR + 8 * p; asm volatile("" : "+v"(kb_), "+v"(vw_));
#pragma unroll
            for (int js = 0; js < 4; ++js) {
                s16x4 kq[4], t0[4], t1[4]; tr_batch_kv(kb_ + (32 * js) * KSTR, vw_ + (32 * js) * VSTR, kq, t0, t1);
                const bf16x8 kf0 = cat8(kq[0], kq[1]), kf1 = cat8(kq[2], kq[3]);
#pragma unroll
                for (int vt = 0; vt < 4; ++vt) { const bf16x8 vf = cat8(t0[vt], t1[vt]); accS[vt][0] = MFMA16(vf, kf0, accS[vt][0]); accS[vt][1] = MFMA16(vf, kf1, accS[vt][1]); }
                {
                    const f32x4 wa = *(const LAS f32x4*)(WKJ + 32 * js + 8 * g), wb = *(const LAS f32x4*)(WKJ + 32 * js + 8 * g + 4);
                    u32x4 pk; pk[0] = cvt_pk_bf16(wa[0], wa[1]); pk[1] = cvt_pk_bf16(wa[2], wa[3]); pk[2] = cvt_pk_bf16(wb[0], wb[1]); pk[3] = cvt_pk_bf16(wb[2], wb[3]);
                    if (i16 != 0) pk = (u32x4){0u, 0u, 0u, 0u};
                    const bf16x8 wf = __builtin_bit_cast(bf16x8, pk);
                    accS[NV - 1][0] = MFMA16(wf, kf0, accS[NV - 1][0]); accS[NV - 1][1] = MFMA16(wf, kf1, accS[NV - 1][1]);
                }
            }
        }
        __syncthreads();
#pragma unroll
        for (int vt = 0; vt < NV; ++vt)
#pragma unroll
            for (int kk = 0; kk < 2; ++kk)
                *(LAS u32x2*)(lds + L_SS + (32 * w + 16 * kk + i16) * SSTR + (16 * vt + 4 * g) * 2) = (u32x2){cvt_pk_bf16(accS[vt][kk][0], accS[vt][kk][1]), cvt_pk_bf16(accS[vt][kk][2], accS[vt][kk][3])};
#undef TOK
    }
    if (!sample) {
        float* SO = P.out + (MLSTM ? OUT_C : OUT_RET) + (size_t)sidx * 65536 + vb * 64;
#pragma unroll
        for (int vt = 0; vt < 4; ++vt)
#pragma unroll
            for (int kk = 0; kk < 2; ++kk) *(f32x4*)(SO + (size_t)(32 * w + 16 * kk + i16) * 256 + 16 * vt + 4 * g) = accS[vt][kk];
        if (MLSTM && vb == 0) {
            if (g == 0) {
#pragma unroll
                for (int kk = 0; kk < 2; ++kk) P.out[OUT_N + (size_t)sidx * 256 + 32 * w + 16 * kk + i16] = accS[NV - 1][kk][0]; }
            if (tid == 0) P.out[OUT_M + sidx] = m_run;
        }
    }
}
__device__ __forceinline__ void phase3(const Params& P, LAS unsigned char* lds) {
    const int c = blockIdx.x, G = gridDim.x;
    int n_items, first, stride;
    if (G == 256) { if (c < 128) { n_items = 4; first = 128 + 3 * c; } else { n_items = 13; first = 128 + 384 + 13 * (c - 128); } stride = 1; }
    else { n_items = (2176 - c + G - 1) / G; first = c; stride = G; }
    for (int it = 0; it < n_items; ++it) {
        int id;
        if (G == 256) id = (c < 128) ? (it == 0 ? c : first + it - 1) : first + it; else id = first + it * stride;
        if (id >= 2176) break;
        __syncthreads();
        int sample, type, rem;
        if (id < 128) { sample = 1; type = id >> 6; rem = id & 63; } else { sample = 0; type = (id - 128) >> 10; rem = (id - 128) & 1023; }
        const int b = rem >> 5, dir = (rem >> 4) & 1, h = (rem >> 2) & 3, vb = rem & 3;
        scan_item(P, lds, type, sample, b, dir, h, vb);
    }
}

typedef const __attribute__((address_space(4))) Params* KParams;
__device__ __forceinline__ Params kparams() {
#if defined(__HIP_DEVICE_COMPILE__)
    KParams p = (KParams)__builtin_amdgcn_kernarg_segment_ptr(); asm volatile("" : "+s"(p)); return *p;
#else
    return Params{};
#endif
}
__global__ void __launch_bounds__(512, 2) mk_fwd(Params Pk) {
    extern __shared__ __attribute__((aligned(16))) unsigned char lds_g[];
    LAS unsigned char* lds = (LAS unsigned char*)lds_g;
    const int ph_lo = Pk.ph_lo, ph_hi = Pk.ph_hi;
#define RUN(x) (ph_lo <= (x) && (x) < ph_hi && PHON(x))
#define SEAM(x) do { if (ph_lo < (x) && (x) < ph_hi) cg::this_grid().sync(); } while (0)
    if (RUN(0)) { const Params P = kparams(); phase0(P, lds); }
    SEAM(1);
    if (RUN(1)) { const Params P = kparams(); phase1(P); }
    SEAM(2);
    if (RUN(2)) { const Params P = kparams(); const float* mod = (const float*)(P.ws + WS_MOD); (void)mod;
        pg8::Gemm g{(const u16*)(P.ws + WS_H), (const u16*)(P.ws + WS_WIN), T_TOK, NINP, 2048};
        pg8::StaticOrder S; S.init(T_TOK, NINP, gridDim.x, blockIdx.x);
        EpiIn E{(u16*)(P.ws + WS_QKV), (u16*)(P.ws + WS_G), (float*)(P.ws + WS_GATES), P.in[11], P.in[12], (const float2*)(P.ws + WS_CS), (LAS float*)(lds + LDS_X)};
        pg8::gemm_phase<EpiIn, pg8::StaticOrder, true, true>(lds, g, S, E);
    }
    SEAM(3);
#ifdef DEBUG_COPY
    if (RUN(3)) { const Params P = kparams();
        const u32x4* src = (const u32x4*)(P.ws + WS_QKV); u32x4* dst = (u32x4*)P.out;
        for (size_t i = (size_t)blockIdx.x * 512 + threadIdx.x; i < 6 * SZQ * 2 / 16; i += (size_t)gridDim.x * 512) dst[i] = src[i];
        const u32x4* s2 = (const u32x4*)(P.ws + WS_GATES); u32x4* d2 = (u32x4*)(P.out + OUT_C);
        for (size_t i = (size_t)blockIdx.x * 512 + threadIdx.x; i < (size_t)T_TOK * 16 * 4 / 16; i += (size_t)gridDim.x * 512) d2[i] = s2[i]; }
#else
    if (RUN(3)) { const Params P = kparams(); phase3(P, lds); }
#endif
    SEAM(4);
    if (RUN(4)) { const Params P = kparams(); phase4(P); }
    SEAM(5);
    if (RUN(5)) { const Params P = kparams(); const float* mod = (const float*)(P.ws + WS_MOD); (void)mod;
        pg8::Gemm g{(const u16*)(P.ws + WS_H), (const u16*)(P.ws + WS_WOUT), T_TOK, 2048, 2048};
        pg8::StaticOrder S; S.init(T_TOK, 2048, gridDim.x, blockIdx.x);
        EpiRes E{P.in[0], P.in[1], P.out, mod, 4096};
        pg8::gemm_phase<EpiRes, pg8::StaticOrder, true, true>(lds, g, S, E);
    }
    SEAM(6);
    if (RUN(6)) { const Params P = kparams(); phase6(P); }
    SEAM(7);
    if (RUN(7)) { const Params P = kparams(); const float* mod = (const float*)(P.ws + WS_MOD); (void)mod;
        pg8::Gemm g{(const u16*)(P.ws + WS_H), (const u16*)(P.ws + WS_WUP), T_TOK, NUP, 2048};
        pg8::StaticOrder S; S.init(T_TOK, NUP, gridDim.x, blockIdx.x);
        EpiUp E{(u16*)(P.ws + WS_ACT), P.in[20], (LAS float*)(lds + LDS_X)};
        pg8::gemm_phase<EpiUp, pg8::StaticOrder, true, true>(lds, g, S, E);
    }
    SEAM(8);
    if (RUN(8)) { const Params P = kparams(); const float* mod = (const float*)(P.ws + WS_MOD); (void)mod;
        pg8::Gemm g{(const u16*)(P.ws + WS_ACT), (const u16*)(P.ws + WS_WDN), T_TOK, 2048, DFF};
        pg8::StaticOrder S; S.init(T_TOK, 2048, gridDim.x, blockIdx.x);
        EpiRes E{P.out, P.out + (size_t)NPROMPT * 2048, P.out, mod, 10240};
        pg8::gemm_phase<EpiRes, pg8::StaticOrder, true, true>(lds, g, S, E);
    }
    SEAM(9);
    if (RUN(9)) { const Params P = kparams(); phase9(P); }
}

extern "C" void kernel_launch(void* const* d_in, const int* in_sizes, int n_in, void* d_out, int out_size, void* d_ws, size_t ws_size, hipStream_t stream) {
    static int grid = 0;
    if (grid == 0) {
        if (n_in != 24 || ws_size < WS_END) { fprintf(stderr, "kernel_launch: unexpected n_in %d / ws_size %zu (need %zu)\n", n_in, ws_size, (size_t)WS_END); grid = -1; return; }
        int dev = 0, cus = 0, per_cu = 0;
        hipGetDevice(&dev); hipDeviceGetAttribute(&cus, hipDeviceAttributeMultiprocessorCount, dev);
        if (hipFuncSetAttribute((const void*)mk_fwd, hipFuncAttributeMaxDynamicSharedMemorySize, LDS_BYTES) != hipSuccess) { fprintf(stderr, "kernel_launch: hipFuncSetAttribute failed\n"); grid = -1; return; }
        if (hipOccupancyMaxActiveBlocksPerMultiprocessor(&per_cu, (const void*)mk_fwd, 512, LDS_BYTES) != hipSuccess || per_cu < 1) { fprintf(stderr, "kernel_launch: occupancy query gives %d\n", per_cu); per_cu = 1; }
        (void)hipGetLastError();
        grid = cus;
        if (grid < 1) grid = 256;
    }
    if (grid < 0) return;
    Params p{};
    for (int i = 0; i < 24; ++i) p.in[i] = (const float*)d_in[i];
    p.out = (float*)d_out; p.ws = (unsigned char*)d_ws;
#if PER_PHASE
    for (int ph = 0; ph < MAXPH; ++ph) { p.ph_lo = ph; p.ph_hi = ph + 1; hipLaunchKernelGGL(mk_fwd, dim3(grid), dim3(512), LDS_BYTES, stream, p); }
#else
    p.ph_lo = 0; p.ph_hi = MAXPH;
    void* args[] = {&p};
    hipError_t e = hipLaunchCooperativeKernel((const void*)mk_fwd, dim3(grid), dim3(512), args, LDS_BYTES, stream);
    if (e != hipSuccess) fprintf(stderr, "cooperative launch failed: %s (grid %d)\n", hipGetErrorString(e), grid);
#endif
}
```

```cpp
#include <hip/hip_runtime.h>
#include <hip/hip_cooperative_groups.h>
#include <cstdio>
#include <cstdint>
namespace pg8 {
#define PG8_LAS __attribute__((address_space(3)))
typedef unsigned short bf16_t;
typedef short bf16x8 __attribute__((ext_vector_type(8)));
typedef float f32x4 __attribute__((ext_vector_type(4)));
typedef unsigned u32x4 __attribute__((ext_vector_type(4)));
constexpr int BM = 256, BK = 64, HALF = 128, HTB = HALF * BK * 2  , STAGE_BYTES = 8 * HTB, NXCD = 8, WGM = 8;

__host__ __device__ __forceinline__ int lds_byte(int r, int c) { const int st = (r >> 4) * 2 + (c >> 5), rr = r & 15, cc = c & 31, ob = rr * 64 + cc * 2; return st * 1024 + (ob ^ (((ob >> 9) & 1) << 5)); }
__host__ __device__ __forceinline__ void stage_rc(int b, int& R, int& C) { const int st = b / 1024, sb = b % 1024, swz = sb ^ (((sb >> 9) & 1) << 5); R = (st >> 1) * 16 + swz / 64; C = (st & 1) * 32 + (swz % 64) / 2; }
__host__ __device__ __forceinline__ int perm32(int rho) { const int n = rho >> 4, i = rho & 15; return 8 * (i >> 2) + 4 * n + (i & 3); }

struct Unit { int pm, pn; };
struct Gemm { const bf16_t* A; const bf16_t* Bt; int M, N, K; };

struct StaticOrder {
    int nM, nN, nwg, G, c;
    __host__ __device__ void init(int M, int N, int G_, int c_) { nM = M / BM; nN = N / BM; nwg = nM * nN; G = G_; c = c_; }
    __host__ __device__ bool next(int i, Unit& u) const {
        const long L = (long)i * G + c; if (L >= nwg) return false;
        int wgid = (int)L; { const int q = nwg / NXCD, r = nwg % NXCD, xcd = wgid % NXCD, off = wgid / NXCD; wgid = (xcd < r ? xcd * (q + 1) : r * (q + 1) + (xcd - r) * q) + off; }
        const int nig = WGM * nN, gid = wgid / nig, fm = gid * WGM, gsz = (nM - fm) < WGM ? (nM - fm) : WGM;
        u.pm = fm + ((wgid % nig) % gsz); u.pn = (wgid % nig) / gsz; return true;
    }
    __device__ __forceinline__ void a_ready(const Unit&) const {}
    __device__ __forceinline__ void done(const Unit&) const {}
};
__device__ __forceinline__ unsigned cvt_pk_bf16(float lo, float hi) { unsigned r; asm volatile("v_cvt_pk_bf16_f32 %0, %1, %2" : "=v"(r) : "v"(lo), "v"(hi)); return r; }
template <class Epi, class Sched, bool ALIGN_EPI = false, bool SP2 = false>
__device__ __forceinline__ void gemm_phase(PG8_LAS unsigned char* lds, const Gemm g, const Sched& S, const Epi& E) {
    const int tid = threadIdx.x, wid = __builtin_amdgcn_readfirstlane(tid >> 6), lane = tid & 63, wr = wid >> 2, wc = wid & 3, fr = lane & 15, fq = lane >> 4;
    const int K = g.K, nt = K / BK;
    unsigned voffA[2], voffB[2];
#pragma unroll
    for (int i = 0; i < 2; ++i) { int R, C; stage_rc(tid * 16 + i * 8192, R, C); const int Rb = Epi::PERM ? ((R & ~31) + perm32(R & 31)) : R;
        voffA[i] = (unsigned)(R * K + C) * 2u; voffB[i] = (unsigned)(Rb * K + C) * 2u; }
    const size_t kstep = (size_t)(BK * 2);
    const size_t hstep = (size_t)HALF * K * 2;
    const size_t tstep = 2 * hstep;
    const unsigned ldsw = (unsigned)wid * 1024u;
    const int aoff = lds_byte(wr * 64 + fr, fq * 8), boff = lds_byte(wc * 32 + fr, fq * 8);
#define PG8_SA(b, h) (((b) * 2 + (h)) * HTB)
#define PG8_SB(b, h) ((4 + (b) * 2 + (h)) * HTB)
#define PG8_STAGE(bufoff, gbase, voff) do { _Pragma("unroll") for (int _i = 0; _i < 2; ++_i) \
        __builtin_amdgcn_global_load_lds((const unsigned*)((const char*)(gbase) + (voff)[_i]), (PG8_LAS unsigned*)(lds + (bufoff) + ldsw + _i * 8192), 16, 0, 0); } while (0)
#define PG8_LDA(dst, b, h) do { _Pragma("unroll") for (int m = 0; m < 4; ++m) _Pragma("unroll") for (int k = 0; k < 2; ++k) dst[m][k] = *(const PG8_LAS bf16x8*)(lds + PG8_SA(b, h) + aoff + m * 2048 + k * 1024); } while (0)
#define PG8_LDB(dst, b, h) do { _Pragma("unroll") for (int n = 0; n < 2; ++n) _Pragma("unroll") for (int k = 0; k < 2; ++k) dst[n][k] = *(const PG8_LAS bf16x8*)(lds + PG8_SB(b, h) + boff + n * 2048 + k * 1024); } while (0)
#define PG8_MMA(ai, bj, At, Bt) do { __builtin_amdgcn_s_setprio(1); _Pragma("unroll") for (int m = 0; m < 4; ++m) _Pragma("unroll") for (int n = 0; n < 2; ++n) _Pragma("unroll") for (int k = 0; k < 2; ++k) \
        acc[ai][bj][m][n] = __builtin_amdgcn_mfma_f32_16x16x32_bf16(Bt[n][k], At[m][k], acc[ai][bj][m][n], 0, 0, 0); __builtin_amdgcn_s_setprio(0); } while (0)
#define PG8_WAIT_V(n) asm volatile("s_waitcnt vmcnt(" #n ")" ::: "memory")
#define PG8_WAIT_L(n) asm volatile("s_waitcnt lgkmcnt(" #n ")" ::: "memory")
#define PG8_BAR __builtin_amdgcn_s_barrier()
#define PG8_SCHED __builtin_amdgcn_sched_barrier(0)
    Unit cur, nxt; int ui = 0;
    if (!S.next(0, cur)) return;
    f32x4 acc[2][2][4][2];
#pragma unroll
    for (int a = 0; a < 2; ++a)
#pragma unroll
        for (int b = 0; b < 2; ++b)
#pragma unroll
            for (int m = 0; m < 4; ++m)
#pragma unroll
                for (int n = 0; n < 2; ++n) acc[a][b][m][n] = (f32x4){0.f, 0.f, 0.f, 0.f};
    bf16x8 At[4][2], B0[2][2], B1[2][2];
    const char* cA = (const char*)g.A + (size_t)cur.pm * tstep; const char* cB = (const char*)g.Bt + (size_t)cur.pn * tstep;
    S.a_ready(cur);
    if constexpr (SP2) {
        PG8_STAGE(PG8_SB(0, 0), cB, voffB); PG8_STAGE(PG8_SB(0, 1), cB + hstep, voffB); PG8_STAGE(PG8_SA(0, 0), cA, voffA); PG8_STAGE(PG8_SA(0, 1), cA + hstep, voffA);
        if (wr == 1) PG8_BAR;
        PG8_WAIT_V(2); PG8_BAR;
        PG8_STAGE(PG8_SB(1, 0), cB + kstep, voffB); PG8_STAGE(PG8_SA(1, 0), cA + kstep, voffA); PG8_STAGE(PG8_SB(1, 1), cB + hstep + kstep, voffB);
        PG8_WAIT_V(6); PG8_BAR;
    } else {
        PG8_STAGE(PG8_SB(0, 0), cB, voffB); PG8_STAGE(PG8_SA(0, 0), cA, voffA); PG8_STAGE(PG8_SB(0, 1), cB + hstep, voffB); PG8_STAGE(PG8_SA(0, 1), cA + hstep, voffA);
        if (wr == 1) PG8_BAR;
        PG8_WAIT_V(4); PG8_BAR;
        PG8_STAGE(PG8_SB(1, 0), cB + kstep, voffB); PG8_STAGE(PG8_SA(1, 0), cA + kstep, voffA); PG8_STAGE(PG8_SB(1, 1), cB + hstep + kstep, voffB);
        PG8_WAIT_V(6); PG8_BAR;
    }
    for (;;) {
        const bool has_next = S.next(ui + 1, nxt);
        const char* nA = has_next ? (const char*)g.A + (size_t)nxt.pm * tstep : cA; const char* nB = has_next ? (const char*)g.Bt + (size_t)nxt.pn * tstep : cB;
        for (int t = 0; t < nt; t += 2) {
            const bool last = (t == nt - 2);
            const char* a1 = cA + (size_t)(t + 1) * kstep;
            const char* a2 = last ? nA : cA + (size_t)(t + 2) * kstep; const char* b2 = last ? nB : cB + (size_t)(t + 2) * kstep;
            const char* a3 = a2 + kstep; const char* b3 = b2 + kstep;
            if (last && has_next) S.a_ready(nxt);
            if constexpr (SP2) {
            PG8_LDB(B0, 0, 0); PG8_LDB(B1, 0, 1); PG8_SCHED; PG8_LDA(At, 0, 0); PG8_STAGE(PG8_SA(1, 1), a1 + hstep, voffA);
            PG8_WAIT_V(8); PG8_WAIT_L(0); PG8_BAR; PG8_MMA(0, 0, At, B0); PG8_MMA(0, 1, At, B1); PG8_BAR; PG8_SCHED;
            PG8_LDA(At, 0, 1); PG8_STAGE(PG8_SB(0, 0), b2, voffB); PG8_STAGE(PG8_SB(0, 1), b2 + hstep, voffB); PG8_STAGE(PG8_SA(0, 0), a2, voffA);
            PG8_WAIT_V(8); PG8_WAIT_L(0); PG8_BAR; PG8_MMA(1, 0, At, B0); PG8_MMA(1, 1, At, B1); PG8_BAR; PG8_SCHED;
            PG8_LDB(B0, 1, 0); PG8_LDB(B1, 1, 1); PG8_SCHED; PG8_LDA(At, 1, 0); PG8_STAGE(PG8_SA(0, 1), a2 + hstep, voffA);
            PG8_WAIT_V(8); PG8_WAIT_L(0); PG8_BAR; PG8_MMA(0, 0, At, B0); PG8_MMA(0, 1, At, B1); PG8_BAR; PG8_SCHED;
            PG8_LDA(At, 1, 1); PG8_STAGE(PG8_SB(1, 0), b3, voffB); PG8_STAGE(PG8_SB(1, 1), b3 + hstep, voffB); PG8_STAGE(PG8_SA(1, 0), a3, voffA);
            PG8_WAIT_V(8); PG8_WAIT_L(0); PG8_BAR; PG8_MMA(1, 0, At, B0); PG8_MMA(1, 1, At, B1); PG8_BAR; PG8_SCHED;
            } else {
            PG8_LDB(B0, 0, 0); PG8_SCHED; PG8_LDA(At, 0, 0); PG8_STAGE(PG8_SA(1, 1), a1 + hstep, voffA);
            PG8_WAIT_L(8); PG8_BAR; PG8_WAIT_L(0); PG8_MMA(0, 0, At, B0); PG8_BAR; PG8_SCHED;
            PG8_LDB(B1, 0, 1); PG8_STAGE(PG8_SB(0, 0), b2, voffB);
            PG8_BAR; PG8_WAIT_L(0); PG8_MMA(0, 1, At, B1); PG8_BAR;
            PG8_LDA(At, 0, 1); PG8_STAGE(PG8_SA(0, 0), a2, voffA);
            PG8_BAR; PG8_WAIT_L(0); PG8_MMA(1, 0, At, B0); PG8_BAR; PG8_SCHED;
            PG8_STAGE(PG8_SB(0, 1), b2 + hstep, voffB);
            PG8_WAIT_V(6); PG8_BAR; PG8_MMA(1, 1, At, B1); PG8_BAR;
            PG8_LDB(B0, 1, 0); PG8_SCHED; PG8_LDA(At, 1, 0); PG8_STAGE(PG8_SA(0, 1), a2 + hstep, voffA);
            PG8_WAIT_L(8); PG8_BAR; PG8_WAIT_L(0); PG8_MMA(0, 0, At, B0); PG8_BAR; PG8_SCHED;
            PG8_LDB(B1, 1, 1); PG8_STAGE(PG8_SB(1, 0), b3, voffB);
            PG8_BAR; PG8_WAIT_L(0); PG8_MMA(0, 1, At, B1); PG8_BAR;
            PG8_LDA(At, 1, 1); PG8_STAGE(PG8_SA(1, 0), a3, voffA);
            PG8_BAR; PG8_WAIT_L(0); PG8_MMA(1, 0, At, B0); PG8_BAR; PG8_SCHED;
            PG8_STAGE(PG8_SB(1, 1), b3 + hstep, voffB);
            PG8_WAIT_V(6); PG8_BAR; PG8_MMA(1, 1, At, B1); PG8_BAR;
            }
        }
        if constexpr (ALIGN_EPI) { if (wr == 0) PG8_BAR; }
        if constexpr (!Epi::AFTER_DRAIN) { E(acc, cur, wr, wc, fr, fq); S.done(cur); }
        if (!has_next) break;
#pragma unroll
        for (int a = 0; a < 2; ++a)
#pragma unroll
            for (int b = 0; b < 2; ++b)
#pragma unroll
                for (int m = 0; m < 4; ++m)
#pragma unroll
                    for (int n = 0; n < 2; ++n) acc[a][b][m][n] = (f32x4){0.f, 0.f, 0.f, 0.f};
        cur = nxt; cA = nA; cB = nB; ++ui;
        if constexpr (ALIGN_EPI) { if (wr == 1) PG8_BAR; }
    }
    PG8_WAIT_V(0);
    if constexpr (!ALIGN_EPI) { if (wr == 0) PG8_BAR; }
    PG8_BAR;
    if constexpr (Epi::AFTER_DRAIN) { E.fused(acc, cur, wr, wc, fr, fq, lds, wid, lane); S.done(cur); }
#undef PG8_SA
#undef PG8_SB
#undef PG8_STAGE
#undef PG8_LDA
#undef PG8_LDB
#undef PG8_MMA
#undef PG8_WAIT_V
#undef PG8_WAIT_L
#undef PG8_BAR
#undef PG8_SCHED
}
}


namespace cg = cooperative_groups;
using pg8::bf16x8; using pg8::f32x4; using pg8::u32x4; using pg8::Unit;
typedef float f32x2_ __attribute__((ext_vector_type(2)));
typedef __bf16 bf16x2_ __attribute__((ext_vector_type(2)));
__device__ __forceinline__ unsigned cvt_pk_bf16(float lo, float hi) { f32x2_ v = {lo, hi}; bf16x2_ b = __builtin_convertvector(v, bf16x2_); return __builtin_bit_cast(unsigned, b); }
typedef unsigned short u16;
typedef unsigned u32x2 __attribute__((ext_vector_type(2)));
typedef short s16x4 __attribute__((ext_vector_type(4)));
#define LAS PG8_LAS

#ifndef ONLY_PH
#define ONLY_PH -1
#endif
#define PHON(x) (ONLY_PH < 0 || ONLY_PH == (x))
#ifndef SCANV
#define SCANV 3
#endif
#ifndef REPEAT_MASK
#define REPEAT_MASK 0
#endif
#define NREP(x) (1 + ((REPEAT_MASK >> (x)) & 1))
#ifndef MAXPH
#define MAXPH 10
#endif
#ifndef PER_PHASE
#define PER_PHASE 0
#endif

constexpr int T_TOK = 12288, NPROMPT = 8192, DFF = 5504, NINP = 8448, NUP = 11008, NPH = 10;
constexpr float ALPHA = 1.189207115002721f;
constexpr size_t SZQ = (size_t)T_TOK * 1024;
constexpr size_t WS_CTR = 0, WS_MOD = 256, WS_CS = WS_MOD + 3 * 12288 * 4, WS_GATES = WS_CS + 32768, WS_WIN = WS_GATES + (size_t)T_TOK * 16 * 4,
                 WS_WOUT = WS_WIN + (size_t)NINP * 2048 * 2, WS_WUP = WS_WOUT + (size_t)2048 * 2048 * 2, WS_WDN = WS_WUP + (size_t)NUP * 2048 * 2,
                 WS_H = WS_WDN + (size_t)2048 * DFF * 2, WS_QKV = WS_H + (size_t)T_TOK * 2048 * 2, WS_G = WS_QKV + 6 * SZQ * 2, WS_END = WS_G + 2 * SZQ * 2,
                 WS_ACT = WS_QKV, WS_BAR = WS_END, WS_END2 = WS_BAR + 16384;
constexpr size_t OUT_RET = (size_t)T_TOK * 2048, OUT_C = OUT_RET + 16777216, OUT_N = OUT_C + 16777216, OUT_M = OUT_N + 65536;
constexpr int LDS_X = pg8::STAGE_BYTES;
constexpr int KSTR = 528, VSTR = 144, SSTR = 176;
constexpr int L_KS = 0, L_VS = L_KS + 128 * KSTR, L_VW = L_VS + 128 * VSTR, L_SS = L_VW + 128 * VSTR, L_AJ = L_SS + 256 * SSTR, L_MI = L_AJ + 512, L_SP = L_MI + 512,
              L_EM = L_SP + 512, L_WK = L_EM + 512, L_IT = L_WK + 512, LDS_BYTES = L_IT + 64;
static_assert(LDS_BYTES <= 160 * 1024 && LDS_X + 6 * 256 * 4 <= LDS_BYTES, "LDS budget");

struct Params { const float* in[24]; float* out; unsigned char* ws; int ph_lo, ph_hi; };

__device__ __forceinline__ float bf2f(unsigned b) { return __uint_as_float(b << 16); }
__device__ __forceinline__ u16 f2bf(float f) { unsigned u = __float_as_uint(f); u += 0x7FFFu + ((u >> 16) & 1u); return (u16)(u >> 16); }
__device__ __forceinline__ float wave_sum(float v) {
#pragma unroll
    for (int o = 32; o >= 1; o >>= 1) v += __shfl_xor(v, o);
    return v; }
__device__ __forceinline__ float silu_f(float x) { return x / (1.f + __expf(-x)); }
__device__ __forceinline__ float sigm_f(float x) { return 1.f / (1.f + __expf(-x)); }
__device__ __forceinline__ float logsig_f(float x) { return fminf(x, 0.f) - log1pf(expf(-fabsf(x))); }
__device__ __forceinline__ const float* xrow(const Params& P, int t) { return t < NPROMPT ? P.in[0] + (size_t)t * 2048 : P.in[1] + (size_t)(t - NPROMPT) * 2048; }
__device__ __forceinline__ int modvec(int t) { return t < NPROMPT ? 0 : 1 + ((t - NPROMPT) >> 11); }
#define LDS_SYNC() do { asm volatile("s_waitcnt lgkmcnt(0)" ::: "memory"); __builtin_amdgcn_s_barrier(); asm volatile("" ::: "memory"); } while (0)

#define XB_TMO      128
#define XB_XCNT(j)  (256  + 64 * (j))
#define XB_XSUB(j)  (1280 + 64 * (j))
#define XB_XGEN(j)  (2304 + 64 * (j))
#define XB_TOP      3328
#define XB_TOPGEN   3392
#define XCD_BAR_WORDS 3456
#define XB_SPIN_CAP (1u << 18)

__device__ __forceinline__ unsigned xb_ld(unsigned* p)              { return __hip_atomic_load(p, __ATOMIC_RELAXED, __HIP_MEMORY_SCOPE_AGENT); }
__device__ __forceinline__ unsigned xb_add(unsigned* p, unsigned v) { return __hip_atomic_fetch_add(p, v, __ATOMIC_RELAXED, __HIP_MEMORY_SCOPE_AGENT); }
__device__ __forceinline__ unsigned xb_xcc_id() { return (unsigned)__builtin_amdgcn_s_getreg((3 << 11) | 20) & 0xFu; }
#define XB_SPIN(cond, bar) do { unsigned _sp = 0; while (cond) { __builtin_amdgcn_s_sleep(1); \
    if ((++_sp & 255u) == 0u) { if (xb_ld(&(bar)[XB_TMO])) break; if (_sp > XB_SPIN_CAP) { atomicAdd(&(bar)[XB_TMO], 1u); break; } } } } while (0)

struct XcdBarrier {
    unsigned* bar; unsigned x;
    volatile LAS unsigned* st;
};

__device__ __forceinline__ XcdBarrier xcd_barrier_post(unsigned* bar, volatile LAS unsigned* st) {
    XcdBarrier b; b.bar = bar; b.x = xb_xcc_id(); b.st = st;
    if (threadIdx.x == 0) (void)xb_add(&bar[XB_XCNT(b.x)], 1u);
    return b;
}
__device__ __forceinline__ void xcd_barrier_complete(unsigned* bar, unsigned x, unsigned& nloc, unsigned& nx) {
    const unsigned G = gridDim.x * gridDim.y * gridDim.z;
    unsigned sum, cnt, mine, sp = 0u;
    for (;;) {
        sum = 0u; cnt = 0u; mine = 0u;
#pragma unroll
        for (unsigned j = 0; j < 16; ++j) { const unsigned c = xb_ld(&bar[XB_XCNT(j)]); sum += c; cnt += (c > 0u) ? 1u : 0u; mine = (j == x) ? c : mine; }
        if (sum == G) break;
        __builtin_amdgcn_s_sleep(1);
        if ((++sp & 255u) == 0u) { if (xb_ld(&bar[XB_TMO])) break; if (sp > XB_SPIN_CAP) { atomicAdd(&bar[XB_TMO], 1u); break; } }
    }
    nloc = mine > 0u ? mine : 1u; nx = cnt > 0u ? cnt : 1u;
}

__device__ __forceinline__ void xcd_barrier(const XcdBarrier& b) {
    asm volatile("s_waitcnt vmcnt(0)" ::: "memory");
    __syncthreads();
    if (threadIdx.x == 0) {
        unsigned* bar = b.bar;
        __builtin_amdgcn_s_waitcnt(0);
        unsigned nloc = b.st[0], nx = b.st[1];
        if (nloc == 0u) { xcd_barrier_complete(bar, b.x, nloc, nx); b.st[0] = nloc; b.st[1] = nx; }
        const unsigned old = xb_add(&bar[XB_XSUB(b.x)], 1u);
        const unsigned gen = old / nloc;
        if (old + 1u == (gen + 1u) * nloc) {
            __builtin_amdgcn_fence(__ATOMIC_RELEASE, "agent");
            asm volatile("s_waitcnt vmcnt(0)" ::: "memory");
            const unsigned og = xb_add(&bar[XB_TOP], 1u);
            const unsigned tg = og / nx;
            if (og + 1u == (tg + 1u) * nx) xb_add(&bar[XB_TOPGEN], 1u);
            else XB_SPIN(xb_ld(&bar[XB_TOPGEN]) == tg, bar);
            __builtin_amdgcn_fence(__ATOMIC_ACQUIRE, "agent");
            xb_add(&bar[XB_XGEN(b.x)], 1u);
            asm volatile("s_waitcnt vmcnt(0)" ::: "memory");
        } else {
            XB_SPIN(xb_ld(&bar[XB_XGEN(b.x)]) == gen, bar);
            __builtin_amdgcn_fence(__ATOMIC_ACQUIRE, "agent");
            asm volatile("s_waitcnt vmcnt(0)" ::: "memory");
        }
    }
    __syncthreads();
}


__device__ __forceinline__ void phase0(const Params& P, LAS unsigned char* lds) {
    const int tid = threadIdx.x, nb = gridDim.x, b = blockIdx.x;
    LAS float* sv = (LAS float*)lds;
    LAS float* red = (LAS float*)(lds + 24576);
    const float* c_in = P.in[6]; const float* c_ctx = P.in[7]; const float* w_mod = P.in[8]; const float* b_mod = P.in[9];
    float* mod = (float*)(P.ws + WS_MOD);
    for (int i = tid; i < 3 * 2048; i += 512) { const int v = i >> 11, k = i & 2047; const float c = v == 0 ? c_ctx[k] : c_in[(v - 1) * 2048 + k]; sv[i] = c / (1.f + expf(-c)); }
    __syncthreads();
    for (int slab = b; slab < 256; slab += nb) {
        const int cq = tid % 12, kl = tid / 12;
        float a0[4] = {0.f, 0.f, 0.f, 0.f}, a1[4] = {0.f, 0.f, 0.f, 0.f}, a2[4] = {0.f, 0.f, 0.f, 0.f};
        if (tid < 504) {
            const float* wp = w_mod + (size_t)48 * slab + 4 * cq;
#pragma unroll 7
            for (int k = kl; k < 2048; k += 42) {
                const f32x4 w = __builtin_nontemporal_load((const f32x4*)(wp + (size_t)k * 12288)); const float s0 = sv[k], s1 = sv[2048 + k], s2 = sv[4096 + k];
#pragma unroll
                for (int e = 0; e < 4; ++e) { a0[e] += s0 * w[e]; a1[e] += s1 * w[e]; a2[e] += s2 * w[e]; }
            }
#pragma unroll
            for (int e = 0; e < 4; ++e) { red[(kl * 3 + 0) * 48 + 4 * cq + e] = a0[e]; red[(kl * 3 + 1) * 48 + 4 * cq + e] = a1[e]; red[(kl * 3 + 2) * 48 + 4 * cq + e] = a2[e]; }
        }
        __syncthreads();
        if (tid < 144) { const int v = tid / 48, col = tid % 48; float s = 0.f; for (int k2 = 0; k2 < 42; ++k2) s += red[(k2 * 3 + v) * 48 + col]; mod[v * 12288 + 48 * slab + col] = s + b_mod[48 * slab + col]; }
        __syncthreads();
    }
    float2* cs = (float2*)(P.ws + WS_CS);
    for (int i = b * 512 + tid; i < 4096; i += nb * 512) { const int pos = i >> 6, j = i & 63; const float inv = exp2f(-(float)j * (13.287712379549449f / 64.f)); const float ang = (float)pos * inv;
        cs[i] = make_float2(__cosf(ang), __sinf(ang)); }
    LAS u16* tl = (LAS u16*)lds;
    constexpr int n_in = 132 * 16, n_out = 32 * 16, n_up = 172 * 16, n_dn = 32 * 43, n_all = n_in + n_out + n_up + n_dn;
    for (int tix = b; tix < n_all; tix += nb) {
        const float* W; u16* Bt; int K, Nsrc, nbk, kb, src, nvalid = 64;
        if (tix < n_in) { W = P.in[10]; Bt = (u16*)(P.ws + WS_WIN); K = 2048; Nsrc = 8208; nbk = tix >> 4; kb = tix & 15;
            const int n0 = nbk * 64, pn = n0 >> 8, p = n0 & 255;
            if (pn < 8) { const int bj = p >> 7, q = p & 127; src = pn * 256 + (q < 64 ? 64 * bj : 128 + 64 * bj); }
            else if (pn < 32) src = n0;
            else { src = 8192; nvalid = (p == 0) ? 16 : 0; } }
        else if (tix < n_in + n_out) { const int r = tix - n_in; W = P.in[16]; Bt = (u16*)(P.ws + WS_WOUT); K = 2048; Nsrc = 2048; nbk = r >> 4; kb = r & 15; src = nbk * 64; }
        else if (tix < n_in + n_out + n_up) { const int r = tix - n_in - n_out; W = P.in[19]; Bt = (u16*)(P.ws + WS_WUP); K = 2048; Nsrc = NUP; nbk = r >> 4; kb = r & 15;
            const int n0 = nbk * 64, pn = n0 >> 8, p = n0 & 255; src = p < 128 ? 128 * pn + p : DFF + 128 * pn + (p - 128); }
        else { const int r = tix - n_in - n_out - n_up; W = P.in[21]; Bt = (u16*)(P.ws + WS_WDN); K = DFF; Nsrc = 2048; nbk = r / 43; kb = r % 43; src = nbk * 64; }
        const int k0 = kb * 128, n0 = nbk * 64;
#pragma unroll
        for (int x = 0; x < 4; ++x) { const int idx = tid + 512 * x, kk = idx >> 4, c4 = idx & 15;
            f32x4 w = (f32x4){0.f, 0.f, 0.f, 0.f};
            if (4 * c4 < nvalid) w = __builtin_nontemporal_load((const f32x4*)(W + (size_t)(k0 + kk) * Nsrc + src + 4 * c4));
#pragma unroll
            for (int e = 0; e < 4; ++e) tl[(4 * c4 + e) * 132 + kk] = f2bf(w[e]); }
        __syncthreads();
#pragma unroll
        for (int x = 0; x < 2; ++x) { const int idx = tid + 512 * x, n = idx >> 4, ch = idx & 15;
            const u32x2 lo = *(const LAS u32x2*)(tl + n * 132 + 8 * ch), hi = *(const LAS u32x2*)(tl + n * 132 + 8 * ch + 4);
            *(u32x4*)(Bt + (size_t)(n0 + n) * K + k0 + 8 * ch) = (u32x4){lo.x, lo.y, hi.x, hi.y}; }
        __syncthreads();
    }
}

__device__ __forceinline__ void ln_stats(const f32x4 (&v)[8], float& mu, float& rstd) {
    float s = 0.f;
#pragma unroll
    for (int i = 0; i < 8; ++i) s += (v[i][0] + v[i][1]) + (v[i][2] + v[i][3]);
    s = wave_sum(s); mu = s * (1.f / 2048.f);
    float q = 0.f;
#pragma unroll
    for (int i = 0; i < 8; ++i) { const f32x4 d = v[i] - mu; q += (d[0] * d[0] + d[1] * d[1]) + (d[2] * d[2] + d[3] * d[3]); }
    q = wave_sum(q); rstd = rsqrtf(q * (1.f / 2048.f) + 1e-6f);
}
__device__ __forceinline__ void phase1(const Params& P) {
    const int lane = threadIdx.x & 63, gw = blockIdx.x * 8 + (threadIdx.x >> 6), nw = gridDim.x * 8;
    const float* mod = (const float*)(P.ws + WS_MOD); u16* H = (u16*)(P.ws + WS_H);
    f32x4 nx[8], msh[8], msc[8]; int vcur = -1;
    if (gw < T_TOK) { const f32x4* xr = (const f32x4*)xrow(P, gw);
#pragma unroll
        for (int i = 0; i < 8; ++i) nx[i] = __builtin_nontemporal_load(xr + lane + 64 * i); }
    for (int t = gw; t < T_TOK; t += nw) {
        f32x4 v[8];
#pragma unroll
        for (int i = 0; i < 8; ++i) v[i] = nx[i];
        const int mv = modvec(t);
        if (mv != vcur) { vcur = mv; const f32x4* md = (const f32x4*)(mod + mv * 12288);
#pragma unroll
            for (int i = 0; i < 8; ++i) { msh[i] = md[lane + 64 * i]; msc[i] = md[512 + lane + 64 * i] + 1.f; } }
        if (t + nw < T_TOK) { const f32x4* xr = (const f32x4*)xrow(P, t + nw);
#pragma unroll
            for (int i = 0; i < 8; ++i) nx[i] = __builtin_nontemporal_load(xr + lane + 64 * i); }
        float mu, rstd; ln_stats(v, mu, rstd);
#pragma unroll
        for (int i = 0; i < 8; ++i) { const int col = 4 * (lane + 64 * i);
            const f32x4 h = (v[i] - mu) * rstd * msc[i] + msh[i];
            *(u32x2*)(H + (size_t)t * 2048 + col) = (u32x2){cvt_pk_bf16(h[0], h[1]), cvt_pk_bf16(h[2], h[3])}; }
    }
}
__device__ __forceinline__ void phase4(const Params& P) {
    const int lane = threadIdx.x & 63, gw = blockIdx.x * 8 + (threadIdx.x >> 6), nw = gridDim.x * 8;
    const u16* O0 = (const u16*)P.out; const u16* O1 = O0 + (size_t)T_TOK * 2048; const u16* G = (const u16*)(P.ws + WS_G); u16* H = (u16*)(P.ws + WS_H);
    u32x2 na[8], nb[8], ng[8]; f32x4 gnr[8];
#pragma unroll
    for (int grp = 0; grp < 8; ++grp) gnr[grp] = grp < 4 ? *(const f32x4*)(P.in[14] + grp * 256 + lane * 4) : *(const f32x4*)(P.in[15] + (grp - 4) * 256 + lane * 4);
    if (gw < T_TOK) {
#pragma unroll
        for (int grp = 0; grp < 8; ++grp) { const int col = grp * 256 + lane * 4;
            na[grp] = *(const u32x2*)(O0 + (size_t)gw * 2048 + col); nb[grp] = *(const u32x2*)(O1 + (size_t)gw * 2048 + col);
            ng[grp] = *(const u32x2*)(G + (grp < 4 ? 0 : SZQ) + (size_t)gw * 1024 + (grp & 3) * 256 + lane * 4); } }
    for (int t = gw; t < T_TOK; t += nw) {
        u32x2 ca[8], cb[8], cg_[8];
#pragma unroll
        for (int grp = 0; grp < 8; ++grp) { ca[grp] = na[grp]; cb[grp] = nb[grp]; cg_[grp] = ng[grp]; }
        if (t + nw < T_TOK) { const int t2 = t + nw;
#pragma unroll
            for (int grp = 0; grp < 8; ++grp) { const int col = grp * 256 + lane * 4;
                na[grp] = *(const u32x2*)(O0 + (size_t)t2 * 2048 + col); nb[grp] = *(const u32x2*)(O1 + (size_t)t2 * 2048 + col);
                ng[grp] = *(const u32x2*)(G + (grp < 4 ? 0 : SZQ) + (size_t)t2 * 1024 + (grp & 3) * 256 + lane * 4); } }
#pragma unroll
        for (int grp = 0; grp < 8; ++grp) {
            const int col = grp * 256 + lane * 4;
            const u32x2 a = ca[grp], b = cb[grp], gt = cg_[grp];
            f32x4 s; s[0] = bf2f(a.x & 0xffffu) + bf2f(b.x & 0xffffu); s[1] = bf2f(a.x >> 16) + bf2f(b.x >> 16); s[2] = bf2f(a.y & 0xffffu) + bf2f(b.y & 0xffffu); s[3] = bf2f(a.y >> 16) + bf2f(b.y >> 16);
            const float mu = wave_sum((s[0] + s[1]) + (s[2] + s[3])) * (1.f / 256.f);
            const f32x4 d = s - mu; const float rstd = rsqrtf(wave_sum((d[0] * d[0] + d[1] * d[1]) + (d[2] * d[2] + d[3] * d[3])) * (1.f / 256.f) + 1e-6f);
            const f32x4 gn = gnr[grp];
            const f32x4 o = d * rstd * gn * (f32x4){bf2f(gt.x & 0xffffu), bf2f(gt.x >> 16), bf2f(gt.y & 0xffffu), bf2f(gt.y >> 16)};
            *(u32x2*)(H + (size_t)t * 2048 + col) = (u32x2){cvt_pk_bf16(o[0], o[1]), cvt_pk_bf16(o[2], o[3])};
        }
    }
}
__device__ __forceinline__ void phase6(const Params& P) {
    const int lane = threadIdx.x & 63, gw = blockIdx.x * 8 + (threadIdx.x >> 6), nw = gridDim.x * 8;
    const float* mod = (const float*)(P.ws + WS_MOD); u16* H = (u16*)(P.ws + WS_H);
    f32x4 nx[8], msh[8], msc[8], lg_[8], lb_[8]; int vcur = -1;
#pragma unroll
    for (int i = 0; i < 8; ++i) { lg_[i] = *(const f32x4*)(P.in[17] + 4 * (lane + 64 * i)); lb_[i] = *(const f32x4*)(P.in[18] + 4 * (lane + 64 * i)); }
    if (gw < T_TOK) { const f32x4* yr = (const f32x4*)(P.out + (size_t)gw * 2048);
#pragma unroll
        for (int i = 0; i < 8; ++i) nx[i] = yr[lane + 64 * i]; }
    for (int t = gw; t < T_TOK; t += nw) {
        f32x4* yr = (f32x4*)(P.out + (size_t)t * 2048); f32x4 v[8];
#pragma unroll
        for (int i = 0; i < 8; ++i) v[i] = nx[i];
        const int mv = modvec(t);
        if (mv != vcur) { vcur = mv; const f32x4* md = (const f32x4*)(mod + mv * 12288 + 6144);
#pragma unroll
            for (int i = 0; i < 8; ++i) { msh[i] = md[lane + 64 * i]; msc[i] = md[512 + lane + 64 * i] + 1.f; } }
        if (t + nw < T_TOK) { const f32x4* y2 = (const f32x4*)(P.out + (size_t)(t + nw) * 2048);
#pragma unroll
            for (int i = 0; i < 8; ++i) nx[i] = y2[lane + 64 * i]; }
        float mu, rstd; ln_stats(v, mu, rstd);
#pragma unroll
        for (int i = 0; i < 8; ++i) { v[i] = (v[i] - mu) * rstd * lg_[i] + lb_[i]; yr[lane + 64 * i] = v[i]; }
        ln_stats(v, mu, rstd);
#pragma unroll
        for (int i = 0; i < 8; ++i) { const int col = 4 * (lane + 64 * i);
            const f32x4 h = (v[i] - mu) * rstd * msc[i] + msh[i];
            *(u32x2*)(H + (size_t)t * 2048 + col) = (u32x2){cvt_pk_bf16(h[0], h[1]), cvt_pk_bf16(h[2], h[3])}; }
    }
}
__device__ __forceinline__ void phase9(const Params& P) {
    const int lane = threadIdx.x & 63, gw = blockIdx.x * 8 + (threadIdx.x >> 6), nw = gridDim.x * 8;
    f32x4 nx[8], lg_[8], lb_[8];
#pragma unroll
    for (int i = 0; i < 8; ++i) { lg_[i] = *(const f32x4*)(P.in[22] + 4 * (lane + 64 * i)); lb_[i] = *(const f32x4*)(P.in[23] + 4 * (lane + 64 * i)); }
    if (gw < T_TOK) { const f32x4* yr = (const f32x4*)(P.out + (size_t)gw * 2048);
#pragma unroll
        for (int i = 0; i < 8; ++i) nx[i] = yr[lane + 64 * i]; }
    for (int t = gw; t < T_TOK; t += nw) {
        f32x4* yr = (f32x4*)(P.out + (size_t)t * 2048); f32x4 v[8];
#pragma unroll
        for (int i = 0; i < 8; ++i) v[i] = nx[i];
        if (t + nw < T_TOK) { const f32x4* y2 = (const f32x4*)(P.out + (size_t)(t + nw) * 2048);
#pragma unroll
            for (int i = 0; i < 8; ++i) nx[i] = y2[lane + 64 * i]; }
        float mu, rstd; ln_stats(v, mu, rstd);
#pragma unroll
        for (int i = 0; i < 8; ++i) yr[lane + 64 * i] = (v[i] - mu) * rstd * lg_[i] + lb_[i];
    }
}

__device__ __forceinline__ void conv4(const f32x4 (&v)[4], const f32x4 bprev, const f32x4 bnext, const f32x4 w0, const f32x4 w1, const f32x4 w2, int lane, int fr, f32x4 (&y)[4]) {
    const int lp = (lane & 48) | ((fr - 1) & 15), ln = (lane & 48) | ((fr + 1) & 15);
#pragma unroll
    for (int m = 0; m < 4; ++m)
#pragma unroll
        for (int e = 0; e < 4; ++e) {
            const float sp_ = (fr == 15) ? (m > 0 ? v[m > 0 ? m - 1 : 0][e] : 0.f) : v[m][e]; float p = __shfl(sp_, lp); if (m == 0 && fr == 0) p = bprev[e];
            const float sn_ = (fr == 0) ? (m < 3 ? v[m < 3 ? m + 1 : 3][e] : 0.f) : v[m][e]; float q = __shfl(sn_, ln); if (m == 3 && fr == 15) q = bnext[e];
            y[m][e] = w0[e] * p + w1[e] * v[m][e] + w2[e] * q;
        }
}
struct EpiRes {
    static constexpr bool PERM = false, AFTER_DRAIN = false;
    const float* xp; const float* xs; float* out; const float* mod; int goff;
    __device__ __forceinline__ void operator()(const f32x4 (&acc)[2][2][4][2], const Unit& u, int wr, int wc, int fr, int fq) const {
        const int v = u.pm < 32 ? 0 : 1 + ((u.pm - 32) >> 3), col0 = u.pn * 256 + wc * 32 + 4 * fq;
        const float* gv = mod + v * 12288 + goff + col0;
        f32x4 g[2][2];
#pragma unroll
        for (int bj = 0; bj < 2; ++bj)
#pragma unroll
            for (int n = 0; n < 2; ++n) g[bj][n] = *(const f32x4*)(gv + bj * 128 + n * 16);
#pragma unroll
        for (int ai = 0; ai < 2; ++ai)
#pragma unroll
            for (int m = 0; m < 4; ++m) { const int r = u.pm * 256 + ai * 128 + wr * 64 + m * 16 + fr;
                const float* bp = (r < NPROMPT ? xp + (size_t)r * 2048 : xs + (size_t)(r - NPROMPT) * 2048) + col0; float* op = out + (size_t)r * 2048 + col0;
#pragma unroll
                for (int bj = 0; bj < 2; ++bj)
#pragma unroll
                    for (int n = 0; n < 2; ++n) { const f32x4 bs = *(const f32x4*)(bp + bj * 128 + n * 16); *(f32x4*)(op + bj * 128 + n * 16) = bs * ALPHA + g[bj][n] * acc[ai][bj][m][n]; }
                asm volatile("" ::: "memory"); }
    }
};
struct EpiUp {
    static constexpr bool PERM = true, AFTER_DRAIN = false;
    u16* act; const float* cw; LAS float* X;
    __device__ __forceinline__ void operator()(const f32x4 (&acc)[2][2][4][2], const Unit& u, int wr, int wc, int fr, int fq) const {
        const int lane = threadIdx.x & 63, lc = wc * 32 + 8 * fq; const bool prompt = u.pm < 32;
#pragma unroll
        for (int ai = 0; ai < 2; ++ai) { const int grp = 2 * ai + wr;
            if (fr == 15 && grp < 3) { *(LAS f32x4*)(X + (2 * grp) * 256 + lc) = acc[ai][0][3][0]; *(LAS f32x4*)(X + (2 * grp) * 256 + lc + 4) = acc[ai][0][3][1]; }
            if (fr == 0 && grp > 0) { *(LAS f32x4*)(X + (2 * grp - 1) * 256 + lc) = acc[ai][0][0][0]; *(LAS f32x4*)(X + (2 * grp - 1) * 256 + lc + 4) = acc[ai][0][0][1]; } }
        LDS_SYNC();
        const int j0 = u.pn * 128 + lc;
#pragma unroll
        for (int ai = 0; ai < 2; ++ai) { const int grp = 2 * ai + wr; f32x4 res[4][2];
#pragma unroll
            for (int n = 0; n < 2; ++n) {
                f32x4 bprev = (f32x4){0.f, 0.f, 0.f, 0.f}, bnext = bprev;
                if (prompt) { if (grp > 0) bprev = *(const LAS f32x4*)(X + (2 * grp - 2) * 256 + lc + 4 * n); if (grp < 3) bnext = *(const LAS f32x4*)(X + (2 * grp + 1) * 256 + lc + 4 * n); }
                const f32x4 w0 = *(const f32x4*)(cw + j0 + 4 * n), w1 = *(const f32x4*)(cw + DFF + j0 + 4 * n), w2 = *(const f32x4*)(cw + 2 * DFF + j0 + 4 * n);
                f32x4 v[4], y[4];
#pragma unroll
                for (int m = 0; m < 4; ++m) v[m] = acc[ai][0][m][n];
                conv4(v, bprev, bnext, w0, w1, w2, lane, fr, y);
#pragma unroll
                for (int m = 0; m < 4; ++m)
#pragma unroll
                    for (int e = 0; e < 4; ++e) res[m][n][e] = silu_f(y[m][e]) * acc[ai][1][m][n][e];
            }
#pragma unroll
            for (int m = 0; m < 4; ++m) { const int r = u.pm * 256 + ai * 128 + wr * 64 + m * 16 + fr;
                *(u32x4*)(act + (size_t)r * DFF + j0) = (u32x4){pg8::cvt_pk_bf16(res[m][0][0], res[m][0][1]), pg8::cvt_pk_bf16(res[m][0][2], res[m][0][3]), pg8::cvt_pk_bf16(res[m][1][0], res[m][1][1]), pg8::cvt_pk_bf16(res[m][1][2], res[m][1][3])}; }
        }
    }
};
struct EpiIn {
    static constexpr bool PERM = true, AFTER_DRAIN = false;
    u16* qkv; u16* gbuf; float* gates; const float* b_gate; const float* cqk; const float2* cs; LAS float* X;
    __device__ __forceinline__ void operator()(const f32x4 (&acc)[2][2][4][2], const Unit& u, int wr, int wc, int fr, int fq) const {
        const int lane = threadIdx.x & 63, cls = u.pn >> 2, hh = u.pn & 3, q0 = wc * 32 + 8 * fq; const bool prompt = u.pm < 32;
        const int rbase = u.pm * 256 + wr * 64 + fr;
        if (cls == 8) {
            if (wc == 0 && fq < 2) {
#pragma unroll
                for (int ai = 0; ai < 2; ++ai)
#pragma unroll
                    for (int m = 0; m < 4; ++m) { const int r = rbase + ai * 128 + m * 16;
#pragma unroll
                        for (int n = 0; n < 2; ++n) *(f32x4*)(gates + (size_t)r * 16 + 8 * fq + 4 * n) = acc[ai][0][m][n] + *(const f32x4*)(b_gate + 8 * fq + 4 * n); } }
        } else if (cls == 4 || cls == 5) {
#pragma unroll
            for (int ai = 0; ai < 2; ++ai) { const int grp = 2 * ai + wr;
#pragma unroll
                for (int bj = 0; bj < 2; ++bj)
#pragma unroll
                    for (int n = 0; n < 2; ++n) { const int xc = bj * 128 + q0 + 4 * n;
                        if (fr == 15 && grp < 3) *(LAS f32x4*)(X + (2 * grp) * 256 + xc) = acc[ai][bj][3][n];
                        if (fr == 0 && grp > 0) *(LAS f32x4*)(X + (2 * grp - 1) * 256 + xc) = acc[ai][bj][0][n]; } }
            LDS_SYNC();
            u16* ob = qkv + (cls == 4 ? 3 : 4) * SZQ; const float scl = cls == 4 ? 1.f : 0.0625f; const int chb = (cls == 4 ? 0 : 1024) + hh * 256;
#pragma unroll
            for (int ai = 0; ai < 2; ++ai) { const int grp = 2 * ai + wr;
#pragma unroll
                for (int bj = 0; bj < 2; ++bj) { f32x4 res[4][2];
#pragma unroll
                    for (int n = 0; n < 2; ++n) { const int xc = bj * 128 + q0 + 4 * n;
                        f32x4 bprev = (f32x4){0.f, 0.f, 0.f, 0.f}, bnext = bprev;
                        if (prompt) { if (grp > 0) bprev = *(const LAS f32x4*)(X + (2 * grp - 2) * 256 + xc); if (grp < 3) bnext = *(const LAS f32x4*)(X + (2 * grp + 1) * 256 + xc); }
                        const f32x4 w0 = *(const f32x4*)(cqk + chb + xc), w1 = *(const f32x4*)(cqk + 2048 + chb + xc), w2 = *(const f32x4*)(cqk + 4096 + chb + xc);
                        f32x4 v[4], y[4];
#pragma unroll
                        for (int m = 0; m < 4; ++m) v[m] = acc[ai][bj][m][n];
                        conv4(v, bprev, bnext, w0, w1, w2, lane, fr, y);
#pragma unroll
                        for (int m = 0; m < 4; ++m)
#pragma unroll
                            for (int e = 0; e < 4; ++e) res[m][n][e] = silu_f(y[m][e]) * scl; }
#pragma unroll
                    for (int m = 0; m < 4; ++m) { const int r = rbase + ai * 128 + m * 16;
                        *(u32x4*)(ob + (size_t)r * 1024 + hh * 256 + bj * 128 + q0) = (u32x4){pg8::cvt_pk_bf16(res[m][0][0], res[m][0][1]), pg8::cvt_pk_bf16(res[m][0][2], res[m][0][3]), pg8::cvt_pk_bf16(res[m][1][0], res[m][1][1]), pg8::cvt_pk_bf16(res[m][1][2], res[m][1][3])}; }
                } }
        } else if (cls < 2) {
            u16* ob = qkv + cls * SZQ; const float scl = cls == 0 ? 1.f : 0.0625f;
            const int d0 = (wc < 2) ? q0 : 128 + (q0 - 64), jf0 = q0 & 63, seg = (u.pm - 32) & 7;
#pragma unroll
            for (int ai = 0; ai < 2; ++ai)
#pragma unroll
                for (int m = 0; m < 4; ++m) { const int r = rbase + ai * 128 + m * 16, rl = ai * 128 + wr * 64 + m * 16 + fr;
                    f32x4 o1[2], o2[2];
#pragma unroll
                    for (int n = 0; n < 2; ++n) { const f32x4 x1 = acc[ai][0][m][n] * scl, x2 = acc[ai][1][m][n] * scl;
                        if (!prompt) { const int pos = (wc < 2) ? seg * 4 + (rl >> 6) : (rl & 63); const float* cp = (const float*)(cs + pos * 64 + jf0 + 4 * n);
                            const f32x4 ca = *(const f32x4*)cp, cb = *(const f32x4*)(cp + 4);
                            const f32x4 co = (f32x4){ca[0], ca[2], cb[0], cb[2]}, si = (f32x4){ca[1], ca[3], cb[1], cb[3]};
                            o1[n] = x1 * co - x2 * si; o2[n] = x1 * si + x2 * co; }
                        else { o1[n] = x1; o2[n] = x2; } }
                    u16* rp = ob + (size_t)r * 1024 + hh * 256 + d0;
                    *(u32x4*)rp = (u32x4){pg8::cvt_pk_bf16(o1[0][0], o1[0][1]), pg8::cvt_pk_bf16(o1[0][2], o1[0][3]), pg8::cvt_pk_bf16(o1[1][0], o1[1][1]), pg8::cvt_pk_bf16(o1[1][2], o1[1][3])};
                    *(u32x4*)(rp + 64) = (u32x4){pg8::cvt_pk_bf16(o2[0][0], o2[0][1]), pg8::cvt_pk_bf16(o2[0][2], o2[0][3]), pg8::cvt_pk_bf16(o2[1][0], o2[1][1]), pg8::cvt_pk_bf16(o2[1][2], o2[1][3])}; }
        } else {
            u16* ob = cls == 2 ? qkv + 2 * SZQ : cls == 6 ? qkv + 5 * SZQ : cls == 3 ? gbuf : gbuf + SZQ;
#pragma unroll
            for (int ai = 0; ai < 2; ++ai)
#pragma unroll
                for (int m = 0; m < 4; ++m) { const int r = rbase + ai * 128 + m * 16;
#pragma unroll
                    for (int bj = 0; bj < 2; ++bj) { f32x4 a = acc[ai][bj][m][0], b = acc[ai][bj][m][1];
                        if (cls == 3) {
#pragma unroll
                            for (int e = 0; e < 4; ++e) { a[e] = silu_f(a[e]); b[e] = silu_f(b[e]); } }
                        if (cls == 7) {
#pragma unroll
                            for (int e = 0; e < 4; ++e) { a[e] = sigm_f(a[e]); b[e] = sigm_f(b[e]); } }
                        *(u32x4*)(ob + (size_t)r * 1024 + hh * 256 + bj * 128 + q0) = (u32x4){pg8::cvt_pk_bf16(a[0], a[1]), pg8::cvt_pk_bf16(a[2], a[3]), pg8::cvt_pk_bf16(b[0], b[1]), pg8::cvt_pk_bf16(b[2], b[3])}; } }
        }
    }
};

__device__ __forceinline__ void tr_issue(s16x4& r, unsigned addr) { asm volatile("ds_read_b64_tr_b16 %0, %1" : "=v"(r) : "v"(addr) : "memory"); }

static_assert(SSTR == 176 && VSTR == 144 && KSTR == 528, "literal offsets in the asm batches");
__device__ __forceinline__ void tr_batch_s(unsigned base, s16x4 (&a)[5], s16x4 (&b)[5]) {
    asm volatile("ds_read_b64_tr_b16 %0, %10\n\tds_read_b64_tr_b16 %1, %10 offset:32\n\tds_read_b64_tr_b16 %2, %10 offset:64\n\tds_read_b64_tr_b16 %3, %10 offset:96\n\tds_read_b64_tr_b16 %4, %10 offset:128\n\t"
                 "ds_read_b64_tr_b16 %5, %10 offset:704\n\tds_read_b64_tr_b16 %6, %10 offset:736\n\tds_read_b64_tr_b16 %7, %10 offset:768\n\tds_read_b64_tr_b16 %8, %10 offset:800\n\tds_read_b64_tr_b16 %9, %10 offset:832\n\t"
                 "s_waitcnt lgkmcnt(0)"
                 : "=&v"(a[0]), "=&v"(a[1]), "=&v"(a[2]), "=&v"(a[3]), "=&v"(a[4]), "=&v"(b[0]), "=&v"(b[1]), "=&v"(b[2]), "=&v"(b[3]), "=&v"(b[4]) : "v"(base) : "memory");
}
__device__ __forceinline__ void tr_batch_v(unsigned base, s16x4 (&a)[4], s16x4 (&b)[4]) {
    asm volatile("ds_read_b64_tr_b16 %0, %8\n\tds_read_b64_tr_b16 %1, %8 offset:32\n\tds_read_b64_tr_b16 %2, %8 offset:64\n\tds_read_b64_tr_b16 %3, %8 offset:96\n\t"
                 "ds_read_b64_tr_b16 %4, %8 offset:2304\n\tds_read_b64_tr_b16 %5, %8 offset:2336\n\tds_read_b64_tr_b16 %6, %8 offset:2368\n\tds_read_b64_tr_b16 %7, %8 offset:2400\n\t"
                 "s_waitcnt lgkmcnt(0)"
                 : "=&v"(a[0]), "=&v"(a[1]), "=&v"(a[2]), "=&v"(a[3]), "=&v"(b[0]), "=&v"(b[1]), "=&v"(b[2]), "=&v"(b[3]) : "v"(base) : "memory");
}
__device__ __forceinline__ void tr_batch_kv(unsigned kb, unsigned vb, s16x4 (&k)[4], s16x4 (&a)[4], s16x4 (&b)[4]) {
    asm volatile("ds_read_b64_tr_b16 %0, %12\n\tds_read_b64_tr_b16 %1, %12 offset:2112\n\tds_read_b64_tr_b16 %2, %12 offset:32\n\tds_read_b64_tr_b16 %3, %12 offset:2144\n\t"
                 "ds_read_b64_tr_b16 %4, %13\n\tds_read_b64_tr_b16 %5, %13 offset:32\n\tds_read_b64_tr_b16 %6, %13 offset:64\n\tds_read_b64_tr_b16 %7, %13 offset:96\n\t"
                 "ds_read_b64_tr_b16 %8, %13 offset:576\n\tds_read_b64_tr_b16 %9, %13 offset:608\n\tds_read_b64_tr_b16 %10, %13 offset:640\n\tds_read_b64_tr_b16 %11, %13 offset:672\n\t"
                 "s_waitcnt lgkmcnt(0)"
                 : "=&v"(k[0]), "=&v"(k[1]), "=&v"(k[2]), "=&v"(k[3]), "=&v"(a[0]), "=&v"(a[1]), "=&v"(a[2]), "=&v"(a[3]), "=&v"(b[0]), "=&v"(b[1]), "=&v"(b[2]), "=&v"(b[3]) : "v"(kb), "v"(vb) : "memory");
}
__device__ __forceinline__ bf16x8 cat8(const s16x4 a, const s16x4 b) { return (bf16x8){a[0], a[1], a[2], a[3], b[0], b[1], b[2], b[3]}; }
#define MFMA16(a, b, c) __builtin_amdgcn_mfma_f32_16x16x32_bf16(a, b, c, 0, 0, 0)

__device__ __forceinline__ void scan_item(const Params& P, LAS unsigned char* lds, const int MLSTM, int sample, int b, int dir, int h, int vb) {
    constexpr int NV = 5;
    const int tid = threadIdx.x, w = __builtin_amdgcn_readfirstlane(tid >> 6), lane = tid & 63, i16 = lane & 15, g = lane >> 4, q = (lane & 15) >> 2, p = lane & 3;
    const unsigned lbase = (unsigned)(uintptr_t)lds;
    const int L = sample ? 2048 : 256, nsteps = L >> 7, tok0 = sample ? NPROMPT + b * 2048 : b * 256;
    const u16* QB = (const u16*)(P.ws + WS_QKV) + (MLSTM ? 3 : 0) * SZQ + h * 256; const u16* KB = QB + SZQ; const u16* VB = QB + 2 * SZQ + vb * 64;
    const float* gates = (const float*)(P.ws + WS_GATES);
    u16* OB = (u16*)P.out + (size_t)dir * T_TOK * 2048 + (MLSTM ? 1024 : 0) + h * 256 + vb * 64;
    LAS float* AJ = (LAS float*)(lds + L_AJ); LAS float* MI = (LAS float*)(lds + L_MI); LAS float* SPI = (LAS float*)(lds + L_SP); LAS float* EMT = (LAS float*)(lds + L_EM); LAS float* WKJ = (LAS float*)(lds + L_WK);
    const int sidx = (b * 2 + dir) * 4 + h;
    f32x4 accS[NV][2];
#pragma unroll
    for (int vt = 0; vt < NV; ++vt)
#pragma unroll
        for (int kk = 0; kk < 2; ++kk) accS[vt][kk] = (f32x4){0.f, 0.f, 0.f, 0.f};
    float m_run = 0.f, lg = 0.f;
    if (sample) {
        const float* S0 = (MLSTM ? P.in[3] : P.in[2]) + (size_t)sidx * 65536 + vb * 64;
#pragma unroll
        for (int vt = 0; vt < 4; ++vt)
#pragma unroll
            for (int kk = 0; kk < 2; ++kk) accS[vt][kk] = *(const f32x4*)(S0 + (size_t)(32 * w + 16 * kk + i16) * 256 + 16 * vt + 4 * g);
        if (MLSTM) {
#pragma unroll
            for (int kk = 0; kk < 2; ++kk) accS[NV - 1][kk][0] = g == 0 ? P.in[4][sidx * 256 + 32 * w + 16 * kk + i16] : 0.f;
            m_run = P.in[5][sidx]; }
    }
    float wk0 = 0.f, wk1 = 0.f, sc = 0.f;
    if (!MLSTM) {
        lg = logsig_f(P.in[13][dir * 4 + h]);
        wk0 = expf(lg * (float)(127 - 2 * lane)); wk1 = expf(lg * (float)(126 - 2 * lane)); sc = expf(lg * 128.f);
        if (w == 0) { WKJ[2 * lane] = wk0; WKJ[2 * lane + 1] = wk1; EMT[2 * lane] = 1.f; EMT[2 * lane + 1] = 1.f; AJ[2 * lane] = -lg * (float)(2 * lane); AJ[2 * lane + 1] = -lg * (float)(2 * lane + 1); MI[2 * lane] = -lg * (float)(2 * lane); MI[2 * lane + 1] = -lg * (float)(2 * lane + 1);
            SPI[2 * lane] = expf(lg * (float)(2 * lane + 1)); SPI[2 * lane + 1] = expf(lg * (float)(2 * lane + 2)); }
    }
#pragma unroll
    for (int vt = 0; vt < NV; ++vt)
#pragma unroll
        for (int kk = 0; kk < 2; ++kk)
            *(LAS u32x2*)(lds + L_SS + (32 * w + 16 * kk + i16) * SSTR + (16 * vt + 4 * g) * 2) = (u32x2){cvt_pk_bf16(accS[vt][kk][0], accS[vt][kk][1]), cvt_pk_bf16(accS[vt][kk][2], accS[vt][kk][3])};

    const int tid0 = tid;
    for (int step = 0; step < nsteps; ++step) {
        const int tb = tok0 + (dir ? L - 128 * (step + 1) : 128 * step);
        int tid = tid0; asm volatile("" : "+v"(tid));
        const int lane = tid & 63, i16 = lane & 15, g = lane >> 4, q = (lane & 15) >> 2, p = lane & 3;
#define TOK(i) (tb + (dir ? 127 - (i) : (i)))
        if (MLSTM) {
            const int t0 = TOK(2 * lane), t1 = TOK(2 * lane + 1);
            const float ig0 = gates[(size_t)t0 * 16 + dir * 8 + h], fg0 = gates[(size_t)t0 * 16 + dir * 8 + 4 + h], ig1 = gates[(size_t)t1 * 16 + dir * 8 + h], fg1 = gates[(size_t)t1 * 16 + dir * 8 + 4 + h];
            const float lf0 = logsig_f(fg0), lf1 = logsig_f(fg1), c1 = lf0 + lf1;
            float inc = c1;
#pragma unroll
            for (int o = 1; o < 64; o <<= 1) { const float t = __shfl_up(inc, o); if (lane >= o) inc += t; }
            const float b0 = inc - c1 + lf0, b1 = inc;
            const float a0 = ig0 - b0, a1 = ig1 - b1, p1 = fmaxf(a0, a1);
            float imx = p1;
#pragma unroll
            for (int o = 1; o < 64; o <<= 1) { const float t = __shfl_up(imx, o); if (lane >= o) imx = fmaxf(imx, t); }
            float emx = __shfl_up(imx, 1); if (lane == 0) emx = -INFINITY;
            const float M0 = fmaxf(m_run, fmaxf(emx, a0)), M1 = fmaxf(m_run, imx);
            const float M127 = __shfl(M1, 63), b127 = __shfl(b1, 63);
            wk0 = expf(a0 - M127); wk1 = expf(a1 - M127); sc = expf(m_run - M127);
            if (w == 0) { AJ[2 * lane] = a0; AJ[2 * lane + 1] = a1; MI[2 * lane] = M0; MI[2 * lane + 1] = M1; SPI[2 * lane] = expf(m_run - M0); SPI[2 * lane + 1] = expf(m_run - M1);
                EMT[2 * lane] = expf(-(b0 + M0)); EMT[2 * lane + 1] = expf(-(b1 + M1)); WKJ[2 * lane] = wk0; WKJ[2 * lane + 1] = wk1; }
            m_run = b127 + M127;
        }
        {
#pragma unroll
            for (int hb = 0; hb < 2; ++hb) { u32x4 kr[4];
#pragma unroll
                for (int x = 0; x < 4; ++x) { const int idx = tid + 512 * (4 * hb + x), row = idx >> 5, ch = idx & 31; kr[x] = *(const u32x4*)(KB + (size_t)TOK(row) * 1024 + ch * 8); }
#pragma unroll
                for (int x = 0; x < 4; ++x) { const int idx = tid + 512 * (4 * hb + x), row = idx >> 5, ch = idx & 31; *(LAS u32x4*)(lds + L_KS + row * KSTR + ch * 16) = kr[x]; }
                asm volatile("" ::: "memory"); }
            u32x4 vr[2];
#pragma unroll
            for (int x = 0; x < 2; ++x) { const int idx = tid + 512 * x, row = idx >> 3, ch = idx & 7; vr[x] = *(const u32x4*)(VB + (size_t)TOK(row) * 1024 + ch * 8); }
#pragma unroll
            for (int x = 0; x < 2; ++x) { const int idx = tid + 512 * x, row = idx >> 3, ch = idx & 7;
                *(LAS u32x4*)(lds + L_VS + row * VSTR + ch * 16) = vr[x];
                const float wa = __shfl(wk0, (row >> 1) & 63), wb = __shfl(wk1, (row >> 1) & 63), wk = (row & 1) ? wb : wa;
                u32x4 o;
#pragma unroll
                for (int e = 0; e < 4; ++e) o[e] = cvt_pk_bf16(bf2f(vr[x][e] & 0xffffu) * wk, bf2f(vr[x][e] >> 16) * wk);
                *(LAS u32x4*)(lds + L_VW + row * VSTR + ch * 16) = o; }
        }
        bf16x8 Qr[8];
        { const u16* qp = QB + (size_t)TOK(16 * w + i16) * 1024 + 8 * g;
#pragma unroll
            for (int ks = 0; ks < 8; ++ks) Qr[ks] = *(const bf16x8*)(qp + 32 * ks); }
        __syncthreads();
        f32x4 ao[4];
#pragma unroll
        for (int vt = 0; vt < 4; ++vt) ao[vt] = (f32x4){0.f, 0.f, 0.f, 0.f};
        float rsum = 0.f;
        const int irow = 16 * w + i16; const float Mi = MI[irow];
        unsigned vbase = lbase + L_VS + (4 * g + q) * VSTR + 8 * p; asm volatile("" : "+v"(vbase));
#pragma unroll
        for (int js = 0; js < 4; ++js) {
            if (2 * js <= w) {
                f32x4 d0 = (f32x4){0.f, 0.f, 0.f, 0.f}, d1 = d0;
                const LAS unsigned char* kp = lds + L_KS + (32 * js + i16) * KSTR + 16 * g;
#pragma unroll
                for (int ks = 0; ks < 8; ++ks) { const bf16x8 k0 = *(const LAS bf16x8*)(kp + 64 * ks), k1 = *(const LAS bf16x8*)(kp + 16 * KSTR + 64 * ks);
                    d0 = MFMA16(k0, Qr[ks], d0); d1 = MFMA16(k1, Qr[ks], d1); if (ks & 1) asm volatile("" ::: "memory"); }
                const f32x4 aj0 = *(const LAS f32x4*)(AJ + 32 * js + 4 * g), aj1 = *(const LAS f32x4*)(AJ + 32 * js + 16 + 4 * g);
                float p0[4], p1[4];
#pragma unroll
                for (int e = 0; e < 4; ++e) { const int j0 = 32 * js + 4 * g + e, j1 = j0 + 16;
                    p0[e] = (j0 <= irow) ? d0[e] * __expf(aj0[e] - Mi) : 0.f; p1[e] = (j1 <= irow) ? d1[e] * __expf(aj1[e] - Mi) : 0.f; rsum += p0[e] + p1[e]; }
                u32x4 pk; pk[0] = cvt_pk_bf16(p0[0], p0[1]); pk[1] = cvt_pk_bf16(p0[2], p0[3]); pk[2] = cvt_pk_bf16(p1[0], p1[1]); pk[3] = cvt_pk_bf16(p1[2], p1[3]);
                const bf16x8 patt = __builtin_bit_cast(bf16x8, pk);
                const unsigned vbs = vbase + (32 * js) * VSTR;
                s16x4 t0[4], t1[4]; tr_batch_v(vbs, t0, t1);
#pragma unroll
                for (int vt = 0; vt < 4; ++vt) ao[vt] = MFMA16(cat8(t0[vt], t1[vt]), patt, ao[vt]);
            }
        }
        f32x4 aqs[NV];
#pragma unroll
        for (int vt = 0; vt < NV; ++vt) aqs[vt] = (f32x4){0.f, 0.f, 0.f, 0.f};
        {
            unsigned sb = lbase + L_SS + (8 * g + q) * SSTR + 8 * p; asm volatile("" : "+v"(sb));
#pragma unroll
            for (int ks = 0; ks < 8; ++ks) {
                s16x4 t0[NV], t1[NV]; tr_batch_s(sb + (32 * ks) * SSTR, t0, t1);
#pragma unroll
                for (int vt = 0; vt < NV; ++vt) aqs[vt] = MFMA16(cat8(t0[vt], t1[vt]), Qr[ks], aqs[vt]);
            }
        }
        {
            const float spi = SPI[irow]; float rden = 1.f;
            if (MLSTM) { rsum += __shfl_xor(rsum, 16); rsum += __shfl_xor(rsum, 32);
                const float qn = __shfl(aqs[NV - 1][0], i16); const float den = rsum + spi * qn; rden = 1.f / fmaxf(fabsf(den), EMT[irow]); }
            u16* op = OB + (size_t)TOK(irow) * 2048 + 4 * g;
#pragma unroll
            for (int vt = 0; vt < 4; ++vt) { const f32x4 o = (ao[vt] + aqs[vt] * spi) * rden; *(u32x2*)(op + 16 * vt) = (u32x2){cvt_pk_bf16(o[0], o[1]), cvt_pk_bf16(o[2], o[3])}; }
        }
#pragma unroll
        for (int vt = 0; vt < NV; ++vt)
#pragma unroll
            for (int kk = 0; kk < 2; ++kk) accS[vt][kk] *= sc;
        {
            unsigned kb_ = lbase + L_KS + (8 * g + q) * KSTR + (32 * w + 4 * p) * 2, vw_ = lbase + L_VW + (8 * g + q) * VSTR + 8 * p; asm volatile("" : "+v"(kb_), "+v"(vw_));
#pragma unroll
            for (int js = 0; js < 4; ++js) {
                s16x4 kq[4], t0[4], t1[4]; tr_batch_kv(kb_ + (32 * js) * KSTR, vw_ + (32 * js) * VSTR, kq, t0, t1);
                const bf16x8 kf0 = cat8(kq[0], kq[1]), kf1 = cat8(kq[2], kq[3]);
#pragma unroll
                for (int vt = 0; vt < 4; ++vt) { const bf16x8 vf = cat8(t0[vt], t1[vt]); accS[vt][0] = MFMA16(vf, kf0, accS[vt][0]); accS[vt][1] = MFMA16(vf, kf1, accS[vt][1]); }
                {
                    const f32x4 wa = *(const LAS f32x4*)(WKJ + 32 * js + 8 * g), wb = *(const LAS f32x4*)(WKJ + 32 * js + 8 * g + 4);
                    u32x4 pk; pk[0] = cvt_pk_bf16(wa[0], wa[1]); pk[1] = cvt_pk_bf16(wa[2], wa[3]); pk[2] = cvt_pk_bf16(wb[0], wb[1]); pk[3] = cvt_pk_bf16(wb[2], wb[3]);
                    if (i16 != 0) pk = (u32x4){0u, 0u, 0u, 0u};
                    const bf16x8 wf = __builtin_bit_cast(bf16x8, pk);
                    accS[NV - 1][0] = MFMA16(wf, kf0, accS[NV - 1][0]); accS[NV - 1][1] = MFMA16(wf, kf1, accS[NV - 1][1]);
                }
            }
        }
        __syncthreads();
#pragma unroll
        for (int vt = 0; vt < NV; ++vt)
#pragma unroll
            for (int kk = 0; kk < 2; ++kk)
                *(LAS u32x2*)(lds + L_SS + (32 * w + 16 * kk + i16) * SSTR + (16 * vt + 4 * g) * 2) = (u32x2){cvt_pk_bf16(accS[vt][kk][0], accS[vt][kk][1]), cvt_pk_bf16(accS[vt][kk][2], accS[vt][kk][3])};
#undef TOK
    }
    if (!sample) {
        float* SO = P.out + (MLSTM ? OUT_C : OUT_RET) + (size_t)sidx * 65536 + vb * 64;
#pragma unroll
        for (int vt = 0; vt < 4; ++vt)
#pragma unroll
            for (int kk = 0; kk < 2; ++kk) *(f32x4*)(SO + (size_t)(32 * w + 16 * kk + i16) * 256 + 16 * vt + 4 * g) = accS[vt][kk];
        if (MLSTM && vb == 0) {
            if (g == 0) {
#pragma unroll
                for (int kk = 0; kk < 2; ++kk) P.out[OUT_N + (size_t)sidx * 256 + 32 * w + 16 * kk + i16] = accS[NV - 1][kk][0]; }
            if (tid == 0) P.out[OUT_M + sidx] = m_run;
        }
    }
}
__device__ __forceinline__ void phase3(const Params& P, LAS unsigned char* lds) {
    const int c = blockIdx.x, G = gridDim.x;
    int n_items, first, stride;
    if (G == 256) { if (c < 128) { n_items = 4; first = 128 + 3 * c; } else { n_items = 13; first = 128 + 384 + 13 * (c - 128); } stride = 1; }
    else { n_items = (2176 - c + G - 1) / G; first = c; stride = G; }
    for (int it = 0; it < n_items; ++it) {
        int id;
        if (G == 256) id = (c < 128) ? (it == 0 ? c : first + it - 1) : first + it; else id = first + it * stride;
        if (id >= 2176) break;
        __syncthreads();
        int sample, type, rem;
        if (id < 128) { sample = 1; type = id >> 6; rem = id & 63; } else { sample = 0; type = (id - 128) >> 10; rem = (id - 128) & 1023; }
        const int b = rem >> 5, dir = (rem >> 4) & 1, h = (rem >> 2) & 3, vb = rem & 3;
        scan_item(P, lds, type, sample, b, dir, h, vb);
    }
}

typedef const __attribute__((address_space(4))) Params* KParams;
__device__ __forceinline__ Params kparams() {
#if defined(__HIP_DEVICE_COMPILE__)
    KParams p = (KParams)__builtin_amdgcn_kernarg_segment_ptr(); asm volatile("" : "+s"(p)); return *p;
#else
    return Params{};
#endif
}
__global__ void __launch_bounds__(512, 2) mk_fwd(Params Pk) {
    extern __shared__ __attribute__((aligned(16))) unsigned char lds_g[];
    LAS unsigned char* lds = (LAS unsigned char*)lds_g;
    const int ph_lo = Pk.ph_lo, ph_hi = Pk.ph_hi;
    volatile LAS unsigned* xst = (volatile LAS unsigned*)(lds + L_IT);
    if (threadIdx.x == 0) { xst[0] = 0u; xst[1] = 0u; }
    __syncthreads();
    const XcdBarrier xb = xcd_barrier_post((unsigned*)(Pk.ws + WS_BAR), xst);
    if (ph_hi == 12345) cg::this_grid().sync();
#define RUN(x) (ph_lo <= (x) && (x) < ph_hi && PHON(x))
#define SEAM(x) do { if (ph_lo < (x) && (x) < ph_hi) xcd_barrier(xb); } while (0)
#ifdef EXTRA_SYNCS
    for (int es = 0; es < EXTRA_SYNCS; ++es) xcd_barrier(xb);
#endif
    if (RUN(0))
_Pragma("unroll")
    for (int rep = 0; rep < NREP(0); ++rep) { if (rep) xcd_barrier(xb); const Params P = kparams(); phase0(P, lds); }
    SEAM(1);
    if (RUN(1))
_Pragma("unroll")
    for (int rep = 0; rep < NREP(1); ++rep) { if (rep) xcd_barrier(xb); const Params P = kparams(); phase1(P); }
    SEAM(2);
    if (RUN(2))
_Pragma("unroll")
    for (int rep = 0; rep < NREP(2); ++rep) { if (rep) xcd_barrier(xb); const Params P = kparams(); const float* mod = (const float*)(P.ws + WS_MOD); (void)mod;
        pg8::Gemm g{(const u16*)(P.ws + WS_H), (const u16*)(P.ws + WS_WIN), T_TOK, NINP, 2048};
        pg8::StaticOrder S; S.init(T_TOK, NINP, gridDim.x, blockIdx.x);
        EpiIn E{(u16*)(P.ws + WS_QKV), (u16*)(P.ws + WS_G), (float*)(P.ws + WS_GATES), P.in[11], P.in[12], (const float2*)(P.ws + WS_CS), (LAS float*)(lds + LDS_X)};
        pg8::gemm_phase<EpiIn, pg8::StaticOrder, true, true>(lds, g, S, E);
    }
    SEAM(3);
    if (RUN(3))
_Pragma("unroll")
    for (int rep = 0; rep < NREP(3); ++rep) { if (rep) xcd_barrier(xb); const Params P = kparams(); phase3(P, lds); }
    SEAM(4);
    if (RUN(4))
_Pragma("unroll")
    for (int rep = 0; rep < NREP(4); ++rep) { if (rep) xcd_barrier(xb); const Params P = kparams(); phase4(P); }
    SEAM(5);
    if (RUN(5))
_Pragma("unroll")
    for (int rep = 0; rep < NREP(5); ++rep) { if (rep) xcd_barrier(xb); const Params P = kparams(); const float* mod = (const float*)(P.ws + WS_MOD); (void)mod;
        pg8::Gemm g{(const u16*)(P.ws + WS_H), (const u16*)(P.ws + WS_WOUT), T_TOK, 2048, 2048};
        pg8::StaticOrder S; S.init(T_TOK, 2048, gridDim.x, blockIdx.x);
        EpiRes E{P.in[0], P.in[1], P.out, mod, 4096};
        pg8::gemm_phase<EpiRes, pg8::StaticOrder, true, true>(lds, g, S, E);
    }
    SEAM(6);
    if (RUN(6))
_Pragma("unroll")
    for (int rep = 0; rep < NREP(6); ++rep) { if (rep) xcd_barrier(xb); const Params P = kparams(); phase6(P); }
    SEAM(7);
    if (RUN(7))
_Pragma("unroll")
    for (int rep = 0; rep < NREP(7); ++rep) { if (rep) xcd_barrier(xb); const Params P = kparams(); const float* mod = (const float*)(P.ws + WS_MOD); (void)mod;
        pg8::Gemm g{(const u16*)(P.ws + WS_H), (const u16*)(P.ws + WS_WUP), T_TOK, NUP, 2048};
        pg8::StaticOrder S; S.init(T_TOK, NUP, gridDim.x, blockIdx.x);
        EpiUp E{(u16*)(P.ws + WS_ACT), P.in[20], (LAS float*)(lds + LDS_X)};
        pg8::gemm_phase<EpiUp, pg8::StaticOrder, true, true>(lds, g, S, E);
    }
    SEAM(8);
    if (RUN(8))
_Pragma("unroll")
    for (int rep = 0; rep < NREP(8); ++rep) { if (rep) xcd_barrier(xb); const Params P = kparams(); const float* mod = (const float*)(P.ws + WS_MOD); (void)mod;
        pg8::Gemm g{(const u16*)(P.ws + WS_ACT), (const u16*)(P.ws + WS_WDN), T_TOK, 2048, DFF};
        pg8::StaticOrder S; S.init(T_TOK, 2048, gridDim.x, blockIdx.x);
        EpiRes E{P.out, P.out + (size_t)NPROMPT * 2048, P.out, mod, 10240};
        pg8::gemm_phase<EpiRes, pg8::StaticOrder, true, true>(lds, g, S, E);
    }
    SEAM(9);
    if (RUN(9))
_Pragma("unroll")
    for (int rep = 0; rep < NREP(9); ++rep) { if (rep) xcd_barrier(xb); const Params P = kparams(); phase9(P); }
}

extern "C" void kernel_launch(void* const* d_in, const int* in_sizes, int n_in, void* d_out, int out_size, void* d_ws, size_t ws_size, hipStream_t stream) {
    static int grid = 0;
    if (grid == 0) {
        if (n_in != 24 || ws_size < WS_END2) { fprintf(stderr, "kernel_launch: unexpected n_in %d / ws_size %zu (need %zu)\n", n_in, ws_size, (size_t)WS_END2); grid = -1; return; }
        int dev = 0, cus = 0, per_cu = 0;
        hipGetDevice(&dev); hipDeviceGetAttribute(&cus, hipDeviceAttributeMultiprocessorCount, dev);
        if (hipFuncSetAttribute((const void*)mk_fwd, hipFuncAttributeMaxDynamicSharedMemorySize, LDS_BYTES) != hipSuccess) { fprintf(stderr, "kernel_launch: hipFuncSetAttribute failed\n"); grid = -1; return; }
        if (hipOccupancyMaxActiveBlocksPerMultiprocessor(&per_cu, (const void*)mk_fwd, 512, LDS_BYTES) != hipSuccess || per_cu < 1) { fprintf(stderr, "kernel_launch: occupancy query gives %d\n", per_cu); per_cu = 1; }
        (void)hipGetLastError();
        grid = cus;
        if (grid < 1) grid = 256;
    }
    if (grid < 0) return;
    if (hipMemsetAsync((char*)d_ws + WS_BAR, 0, XCD_BAR_WORDS * 4, stream) != hipSuccess) { fprintf(stderr, "kernel_launch: memset of the barrier words failed\n"); return; }
    Params p{};
    for (int i = 0; i < 24; ++i) p.in[i] = (const float*)d_in[i];
    p.out = (float*)d_out; p.ws = (unsigned char*)d_ws;
#if PER_PHASE
    for (int ph = 0; ph < MAXPH; ++ph) { p.ph_lo = ph; p.ph_hi = ph + 1; hipLaunchKernelGGL(mk_fwd, dim3(grid), dim3(512), LDS_BYTES, stream, p); }
#else
    p.ph_lo = 0; p.ph_hi = MAXPH;
    void* args[] = {&p};
    hipError_t e = hipLaunchCooperativeKernel((const void*)mk_fwd, dim3(grid), dim3(512), args, LDS_BYTES, stream);
    if (e != hipSuccess) fprintf(stderr, "cooperative launch failed: %s (grid %d)\n", hipGetErrorString(e), grid);
#endif
}
```

```cpp
#include <hip/hip_runtime.h>
#include <hip/hip_cooperative_groups.h>
#include <cstdio>
#include <cstdint>
namespace pg8 {
#define PG8_LAS __attribute__((address_space(3)))
typedef unsigned short bf16_t;
typedef short bf16x8 __attribute__((ext_vector_type(8)));
typedef float f32x4 __attribute__((ext_vector_type(4)));
typedef unsigned u32x4 __attribute__((ext_vector_type(4)));
constexpr int BM = 256, BK = 64, HALF = 128, HTB = HALF * BK * 2  , STAGE_BYTES = 8 * HTB, NXCD = 8, WGM = 8;

__host__ __device__ __forceinline__ int lds_byte(int r, int c) { const int st = (r >> 4) * 2 + (c >> 5), rr = r & 15, cc = c & 31, ob = rr * 64 + cc * 2; return st * 1024 + (ob ^ (((ob >> 9) & 1) << 5)); }
__host__ __device__ __forceinline__ void stage_rc(int b, int& R, int& C) { const int st = b / 1024, sb = b % 1024, swz = sb ^ (((sb >> 9) & 1) << 5); R = (st >> 1) * 16 + swz / 64; C = (st & 1) * 32 + (swz % 64) / 2; }
__host__ __device__ __forceinline__ int perm32(int rho) { const int n = rho >> 4, i = rho & 15; return 8 * (i >> 2) + 4 * n + (i & 3); }

struct Unit { int pm, pn; };
struct Gemm { const bf16_t* A; const bf16_t* Bt; int M, N, K; };

struct StaticOrder {
    int nM, nN, nwg, G, c;
    __host__ __device__ void init(int M, int N, int G_, int c_) { nM = M / BM; nN = N / BM; nwg = nM * nN; G = G_; c = c_; }
    __host__ __device__ bool next(int i, Unit& u) const {
        const long L = (long)i * G + c; if (L >= nwg) return false;
        int wgid = (int)L; { const int q = nwg / NXCD, r = nwg % NXCD, xcd = wgid % NXCD, off = wgid / NXCD; wgid = (xcd < r ? xcd * (q + 1) : r * (q + 1) + (xcd - r) * q) + off; }
        const int nig = WGM * nN, gid = wgid / nig, fm = gid * WGM, gsz = (nM - fm) < WGM ? (nM - fm) : WGM;
        u.pm = fm + ((wgid % nig) % gsz); u.pn = (wgid % nig) / gsz; return true;
    }
    __device__ __forceinline__ void a_ready(const Unit&) const {}
    __device__ __forceinline__ void done(const Unit&) const {}
};
__device__ __forceinline__ unsigned cvt_pk_bf16(float lo, float hi) { unsigned r; asm volatile("v_cvt_pk_bf16_f32 %0, %1, %2" : "=v"(r) : "v"(lo), "v"(hi)); return r; }
template <class Epi, class Sched, bool ALIGN_EPI = false, bool SP2 = false>
__device__ __forceinline__ void gemm_phase(PG8_LAS unsigned char* lds, const Gemm g, const Sched& S, const Epi& E) {
    const int tid = threadIdx.x, wid = __builtin_amdgcn_readfirstlane(tid >> 6), lane = tid & 63, wr = wid >> 2, wc = wid & 3, fr = lane & 15, fq = lane >> 4;
    const int K = g.K, nt = K / BK;
    unsigned voffA[2], voffB[2];
#pragma unroll
    for (int i = 0; i < 2; ++i) { int R, C; stage_rc(tid * 16 + i * 8192, R, C); const int Rb = Epi::PERM ? ((R & ~31) + perm32(R & 31)) : R;
        voffA[i] = (unsigned)(R * K + C) * 2u; voffB[i] = (unsigned)(Rb * K + C) * 2u; }
    const size_t kstep = (size_t)(BK * 2);
    const size_t hstep = (size_t)HALF * K * 2;
    const size_t tstep = 2 * hstep;
    const unsigned ldsw = (unsigned)wid * 1024u;
    const int aoff = lds_byte(wr * 64 + fr, fq * 8), boff = lds_byte(wc * 32 + fr, fq * 8);
#define PG8_SA(b, h) (((b) * 2 + (h)) * HTB)
#define PG8_SB(b, h) ((4 + (b) * 2 + (h)) * HTB)
#define PG8_STAGE(bufoff, gbase, voff) do { _Pragma("unroll") for (int _i = 0; _i < 2; ++_i) \
        __builtin_amdgcn_global_load_lds((const unsigned*)((const char*)(gbase) + (voff)[_i]), (PG8_LAS unsigned*)(lds + (bufoff) + ldsw + _i * 8192), 16, 0, 0); } while (0)
#define PG8_LDA(dst, b, h) do { _Pragma("unroll") for (int m = 0; m < 4; ++m) _Pragma("unroll") for (int k = 0; k < 2; ++k) dst[m][k] = *(const PG8_LAS bf16x8*)(lds + PG8_SA(b, h) + aoff + m * 2048 + k * 1024); } while (0)
#define PG8_LDB(dst, b, h) do { _Pragma("unroll") for (int n = 0; n < 2; ++n) _Pragma("unroll") for (int k = 0; k < 2; ++k) dst[n][k] = *(const PG8_LAS bf16x8*)(lds + PG8_SB(b, h) + boff + n * 2048 + k * 1024); } while (0)
#define PG8_MMA(ai, bj, At, Bt) do { __builtin_amdgcn_s_setprio(1); _Pragma("unroll") for (int m = 0; m < 4; ++m) _Pragma("unroll") for (int n = 0; n < 2; ++n) _Pragma("unroll") for (int k = 0; k < 2; ++k) \
        acc[ai][bj][m][n] = __builtin_amdgcn_mfma_f32_16x16x32_bf16(Bt[n][k], At[m][k], acc[ai][bj][m][n], 0, 0, 0); __builtin_amdgcn_s_setprio(0); } while (0)
#define PG8_WAIT_V(n) asm volatile("s_waitcnt vmcnt(" #n ")" ::: "memory")
#define PG8_WAIT_L(n) asm volatile("s_waitcnt lgkmcnt(" #n ")" ::: "memory")
#define PG8_BAR __builtin_amdgcn_s_barrier()
#define PG8_SCHED __builtin_amdgcn_sched_barrier(0)
    Unit cur, nxt; int ui = 0;
    if (!S.next(0, cur)) return;
    f32x4 acc[2][2][4][2];
#pragma unroll
    for (int a = 0; a < 2; ++a)
#pragma unroll
        for (int b = 0; b < 2; ++b)
#pragma unroll
            for (int m = 0; m < 4; ++m)
#pragma unroll
                for (int n = 0; n < 2; ++n) acc[a][b][m][n] = (f32x4){0.f, 0.f, 0.f, 0.f};
    bf16x8 At[4][2], B0[2][2], B1[2][2];
    const char* cA = (const char*)g.A + (size_t)cur.pm * tstep; const char* cB = (const char*)g.Bt + (size_t)cur.pn * tstep;
    S.a_ready(cur);
    if constexpr (SP2) {
        PG8_STAGE(PG8_SB(0, 0), cB, voffB); PG8_STAGE(PG8_SB(0, 1), cB + hstep, voffB); PG8_STAGE(PG8_SA(0, 0), cA, voffA); PG8_STAGE(PG8_SA(0, 1), cA + hstep, voffA);
        if (wr == 1) PG8_BAR;
        PG8_WAIT_V(2); PG8_BAR;
        PG8_STAGE(PG8_SB(1, 0), cB + kstep, voffB); PG8_STAGE(PG8_SA(1, 0), cA + kstep, voffA); PG8_STAGE(PG8_SB(1, 1), cB + hstep + kstep, voffB);
        PG8_WAIT_V(6); PG8_BAR;
    } else {
        PG8_STAGE(PG8_SB(0, 0), cB, voffB); PG8_STAGE(PG8_SA(0, 0), cA, voffA); PG8_STAGE(PG8_SB(0, 1), cB + hstep, voffB); PG8_STAGE(PG8_SA(0, 1), cA + hstep, voffA);
        if (wr == 1) PG8_BAR;
        PG8_WAIT_V(4); PG8_BAR;
        PG8_STAGE(PG8_SB(1, 0), cB + kstep, voffB); PG8_STAGE(PG8_SA(1, 0), cA + kstep, voffA); PG8_STAGE(PG8_SB(1, 1), cB + hstep + kstep, voffB);
        PG8_WAIT_V(6); PG8_BAR;
    }
    for (;;) {
        const bool has_next = S.next(ui + 1, nxt);
        const char* nA = has_next ? (const char*)g.A + (size_t)nxt.pm * tstep : cA; const char* nB = has_next ? (const char*)g.Bt + (size_t)nxt.pn * tstep : cB;
        for (int t = 0; t < nt; t += 2) {
            const bool last = (t == nt - 2);
            const char* a1 = cA + (size_t)(t + 1) * kstep;
            const char* a2 = last ? nA : cA + (size_t)(t + 2) * kstep; const char* b2 = last ? nB : cB + (size_t)(t + 2) * kstep;
            const char* a3 = a2 + kstep; const char* b3 = b2 + kstep;
            if (last && has_next) S.a_ready(nxt);
            if constexpr (SP2) {
            PG8_LDB(B0, 0, 0); PG8_LDB(B1, 0, 1); PG8_SCHED; PG8_LDA(At, 0, 0); PG8_STAGE(PG8_SA(1, 1), a1 + hstep, voffA);
            PG8_WAIT_V(8); PG8_WAIT_L(0); PG8_BAR; PG8_MMA(0, 0, At, B0); PG8_MMA(0, 1, At, B1); PG8_BAR; PG8_SCHED;
            PG8_LDA(At, 0, 1); PG8_STAGE(PG8_SB(0, 0), b2, voffB); PG8_STAGE(PG8_SB(0, 1), b2 + hstep, voffB); PG8_STAGE(PG8_SA(0, 0), a2, voffA);
            PG8_WAIT_V(8); PG8_WAIT_L(0); PG8_BAR; PG8_MMA(1, 0, At, B0); PG8_MMA(1, 1, At, B1); PG8_BAR; PG8_SCHED;
            PG8_LDB(B0, 1, 0); PG8_LDB(B1, 1, 1); PG8_SCHED; PG8_LDA(At, 1, 0); PG8_STAGE(PG8_SA(0, 1), a2 + hstep, voffA);
            PG8_WAIT_V(8); PG8_WAIT_L(0); PG8_BAR; PG8_MMA(0, 0, At, B0); PG8_MMA(0, 1, At, B1); PG8_BAR; PG8_SCHED;
            PG8_LDA(At, 1, 1); PG8_STAGE(PG8_SB(1, 0), b3, voffB); PG8_STAGE(PG8_SB(1, 1), b3 + hstep, voffB); PG8_STAGE(PG8_SA(1, 0), a3, voffA);
            PG8_WAIT_V(8); PG8_WAIT_L(0); PG8_BAR; PG8_MMA(1, 0, At, B0); PG8_MMA(1, 1, At, B1); PG8_BAR; PG8_SCHED;
            } else {
            PG8_LDB(B0, 0, 0); PG8_SCHED; PG8_LDA(At, 0, 0); PG8_STAGE(PG8_SA(1, 1), a1 + hstep, voffA);
            PG8_WAIT_L(8); PG8_BAR; PG8_WAIT_L(0); PG8_MMA(0, 0, At, B0); PG8_BAR; PG8_SCHED;
            PG8_LDB(B1, 0, 1); PG8_STAGE(PG8_SB(0, 0), b2, voffB);
            PG8_BAR; PG8_WAIT_L(0); PG8_MMA(0, 1, At, B1); PG8_BAR;
            PG8_LDA(At, 0, 1); PG8_STAGE(PG8_SA(0, 0), a2, voffA);
            PG8_BAR; PG8_WAIT_L(0); PG8_MMA(1, 0, At, B0); PG8_BAR; PG8_SCHED;
            PG8_STAGE(PG8_SB(0, 1), b2 + hstep, voffB);
            PG8_WAIT_V(6); PG8_BAR; PG8_MMA(1, 1, At, B1); PG8_BAR;
            PG8_LDB(B0, 1, 0); PG8_SCHED; PG8_LDA(At, 1, 0); PG8_STAGE(PG8_SA(0, 1), a2 + hstep, voffA);
            PG8_WAIT_L(8); PG8_BAR; PG8_WAIT_L(0); PG8_MMA(0, 0, At, B0); PG8_BAR; PG8_SCHED;
            PG8_LDB(B1, 1, 1); PG8_STAGE(PG8_SB(1, 0), b3, voffB);
            PG8_BAR; PG8_WAIT_L(0); PG8_MMA(0, 1, At, B1); PG8_BAR;
            PG8_LDA(At, 1, 1); PG8_STAGE(PG8_SA(1, 0), a3, voffA);
            PG8_BAR; PG8_WAIT_L(0); PG8_MMA(1, 0, At, B0); PG8_BAR; PG8_SCHED;
            PG8_STAGE(PG8_SB(1, 1), b3 + hstep, voffB);
            PG8_WAIT_V(6); PG8_BAR; PG8_MMA(1, 1, At, B1); PG8_BAR;
            }
        }
        if constexpr (ALIGN_EPI) { if (wr == 0) PG8_BAR; }
        if constexpr (!Epi::AFTER_DRAIN) { E(acc, cur, wr, wc, fr, fq); S.done(cur); }
        if (!has_next) break;
#pragma unroll
        for (int a = 0; a < 2; ++a)
#pragma unroll
            for (int b = 0; b < 2; ++b)
#pragma unroll
                for (int m = 0; m < 4; ++m)
#pragma unroll
                    for (int n = 0; n < 2; ++n) acc[a][b][m][n] = (f32x4){0.f, 0.f, 0.f, 0.f};
        cur = nxt; cA = nA; cB = nB; ++ui;
        if constexpr (ALIGN_EPI) { if (wr == 1) PG8_BAR; }
    }
    PG8_WAIT_V(0);
    if constexpr (!ALIGN_EPI) { if (wr == 0) PG8_BAR; }
    PG8_BAR;
    if constexpr (Epi::AFTER_DRAIN) { E.fused(acc, cur, wr, wc, fr, fq, lds, wid, lane); S.done(cur); }
#undef PG8_SA
#undef PG8_SB
#undef PG8_STAGE
#undef PG8_LDA
#undef PG8_LDB
#undef PG8_MMA
#undef PG8_WAIT_V
#undef PG8_WAIT_L
#undef PG8_BAR
#undef PG8_SCHED
}
}


namespace cg = cooperative_groups;
using pg8::bf16x8; using pg8::f32x4; using pg8::u32x4; using pg8::Unit;
typedef float f32x2_ __attribute__((ext_vector_type(2)));
typedef __bf16 bf16x2_ __attribute__((ext_vector_type(2)));
__device__ __forceinline__ unsigned cvt_pk_bf16(float lo, float hi) { f32x2_ v = {lo, hi}; bf16x2_ b = __builtin_convertvector(v, bf16x2_); return __builtin_bit_cast(unsigned, b); }
typedef unsigned short u16;
typedef unsigned u32x2 __attribute__((ext_vector_type(2)));
typedef short s16x4 __attribute__((ext_vector_type(4)));
#define LAS PG8_LAS

#ifndef ONLY_PH
#define ONLY_PH -1
#endif
#define PHON(x) (ONLY_PH < 0 || ONLY_PH == (x))
#ifndef SCANV
#define SCANV 3
#endif
#ifndef REPEAT_MASK
#define REPEAT_MASK 0
#endif
#define NREP(x) (1 + ((REPEAT_MASK >> (x)) & 1))
#ifndef MAXPH
#define MAXPH 10
#endif
#ifndef PER_PHASE
#define PER_PHASE 0
#endif

constexpr int T_TOK = 12288, NPROMPT = 8192, DFF = 5504, NINP = 8448, NUP = 11008, NPH = 10;
constexpr float ALPHA = 1.189207115002721f;
constexpr size_t SZQ = (size_t)T_TOK * 1024;
constexpr size_t WS_CTR = 0, WS_MOD = 256, WS_CS = WS_MOD + 3 * 12288 * 4, WS_GATES = WS_CS + 32768, WS_WIN = WS_GATES + (size_t)T_TOK * 16 * 4,
                 WS_WOUT = WS_WIN + (size_t)NINP * 2048 * 2, WS_WUP = WS_WOUT + (size_t)2048 * 2048 * 2, WS_WDN = WS_WUP + (size_t)NUP * 2048 * 2,
                 WS_H = WS_WDN + (size_t)2048 * DFF * 2, WS_QKV = WS_H + (size_t)T_TOK * 2048 * 2, WS_G = WS_QKV + 6 * SZQ * 2, WS_END = WS_G + 2 * SZQ * 2,
                 WS_ACT = WS_QKV, WS_BAR = WS_END, WS_END2 = WS_BAR + 16384;
constexpr size_t OUT_RET = (size_t)T_TOK * 2048, OUT_C = OUT_RET + 16777216, OUT_N = OUT_C + 16777216, OUT_M = OUT_N + 65536;
constexpr int LDS_X = pg8::STAGE_BYTES;
constexpr int KSTR = 528, VSTR = 144, SSTR = 176;
constexpr int L_KS = 0, L_VS = L_KS + 128 * KSTR, L_VW = L_VS + 128 * VSTR, L_SS = L_VW + 128 * VSTR, L_AJ = L_SS + 256 * SSTR, L_MI = L_AJ + 512, L_SP = L_MI + 512,
              L_EM = L_SP + 512, L_WK = L_EM + 512, L_IT = L_WK + 512, LDS_BYTES = L_IT + 64;
static_assert(LDS_BYTES <= 160 * 1024 && LDS_X + 6 * 256 * 4 <= LDS_BYTES, "LDS budget");

struct Params { const float* in[24]; float* out; unsigned char* ws; int ph_lo, ph_hi; };

__device__ __forceinline__ float bf2f(unsigned b) { return __uint_as_float(b << 16); }
__device__ __forceinline__ u16 f2bf(float f) { unsigned u = __float_as_uint(f); u += 0x7FFFu + ((u >> 16) & 1u); return (u16)(u >> 16); }
__device__ __forceinline__ float wave_sum(float v) {
#pragma unroll
    for (int o = 32; o >= 1; o >>= 1) v += __shfl_xor(v, o);
    return v; }
__device__ __forceinline__ float silu_f(float x) { return x / (1.f + __expf(-x)); }
__device__ __forceinline__ float sigm_f(float x) { return 1.f / (1.f + __expf(-x)); }
__device__ __forceinline__ float logsig_f(float x) { return fminf(x, 0.f) - log1pf(expf(-fabsf(x))); }
__device__ __forceinline__ const float* xrow(const Params& P, int t) { return t < NPROMPT ? P.in[0] + (size_t)t * 2048 : P.in[1] + (size_t)(t - NPROMPT) * 2048; }
__device__ __forceinline__ int modvec(int t) { return t < NPROMPT ? 0 : 1 + ((t - NPROMPT) >> 11); }
#define LDS_SYNC() do { asm volatile("s_waitcnt lgkmcnt(0)" ::: "memory"); __builtin_amdgcn_s_barrier(); asm volatile("" ::: "memory"); } while (0)

#define XB_TMO      128
#define XB_XCNT(j)  (256  + 64 * (j))
#define XB_XSUB(j)  (1280 + 64 * (j))
#define XB_XGEN(j)  (2304 + 64 * (j))
#define XB_TOP      3328
#define XB_TOPGEN   3392
#define XCD_BAR_WORDS 3456
#define XB_SPIN_CAP (1u << 18)

__device__ __forceinline__ unsigned xb_ld(unsigned* p)              { return __hip_atomic_load(p, __ATOMIC_RELAXED, __HIP_MEMORY_SCOPE_AGENT); }
__device__ __forceinline__ unsigned xb_add(unsigned* p, unsigned v) { return __hip_atomic_fetch_add(p, v, __ATOMIC_RELAXED, __HIP_MEMORY_SCOPE_AGENT); }
__device__ __forceinline__ unsigned xb_xcc_id() { return (unsigned)__builtin_amdgcn_s_getreg((3 << 11) | 20) & 0xFu; }
#define XB_SPIN(cond, bar) do { unsigned _sp = 0; while (cond) { __builtin_amdgcn_s_sleep(1); \
    if ((++_sp & 255u) == 0u) { if (xb_ld(&(bar)[XB_TMO])) break; if (_sp > XB_SPIN_CAP) { atomicAdd(&(bar)[XB_TMO], 1u); break; } } } } while (0)

struct XcdBarrier {
    unsigned* bar; unsigned x;
    volatile LAS unsigned* st;
};

__device__ __forceinline__ XcdBarrier xcd_barrier_post(unsigned* bar, volatile LAS unsigned* st) {
    XcdBarrier b; b.bar = bar; b.x = xb_xcc_id(); b.st = st;
    if (threadIdx.x == 0) (void)xb_add(&bar[XB_XCNT(b.x)], 1u);
    return b;
}
__device__ __forceinline__ void xcd_barrier_complete(unsigned* bar, unsigned x, unsigned& nloc, unsigned& nx) {
    const unsigned G = gridDim.x * gridDim.y * gridDim.z;
    unsigned sum, cnt, mine, sp = 0u;
    for (;;) {
        sum = 0u; cnt = 0u; mine = 0u;
#pragma unroll
        for (unsigned j = 0; j < 16; ++j) { const unsigned c = xb_ld(&bar[XB_XCNT(j)]); sum += c; cnt += (c > 0u) ? 1u : 0u; mine = (j == x) ? c : mine; }
        if (sum == G) break;
        __builtin_amdgcn_s_sleep(1);
        if ((++sp & 255u) == 0u) { if (xb_ld(&bar[XB_TMO])) break; if (sp > XB_SPIN_CAP) { atomicAdd(&bar[XB_TMO], 1u); break; } }
    }
    nloc = mine > 0u ? mine : 1u; nx = cnt > 0u ? cnt : 1u;
}

__device__ __forceinline__ void xcd_barrier(const XcdBarrier& b) {
    asm volatile("s_waitcnt vmcnt(0)" ::: "memory");
    __syncthreads();
    if (threadIdx.x == 0) {
        unsigned* bar = b.bar;
        __builtin_amdgcn_s_waitcnt(0);
        unsigned nloc = b.st[0], nx = b.st[1];
        if (nloc == 0u) { xcd_barrier_complete(bar, b.x, nloc, nx); b.st[0] = nloc; b.st[1] = nx; }
        const unsigned old = xb_add(&bar[XB_XSUB(b.x)], 1u);
        const unsigned gen = old / nloc;
        if (old + 1u == (gen + 1u) * nloc) {
            __builtin_amdgcn_fence(__ATOMIC_RELEASE, "agent");
            asm volatile("s_waitcnt vmcnt(0)" ::: "memory");
            const unsigned og = xb_add(&bar[XB_TOP], 1u);
            const unsigned tg = og / nx;
            if (og + 1u == (tg + 1u) * nx) xb_add(&bar[XB_TOPGEN], 1u);
            else XB_SPIN(xb_ld(&bar[XB_TOPGEN]) == tg, bar);
            __builtin_amdgcn_fence(__ATOMIC_ACQUIRE, "agent");
            xb_add(&bar[XB_XGEN(b.x)], 1u);
            asm volatile("s_waitcnt vmcnt(0)" ::: "memory");
        } else {
            XB_SPIN(xb_ld(&bar[XB_XGEN(b.x)]) == gen, bar);
            __builtin_amdgcn_fence(__ATOMIC_ACQUIRE, "agent");
            asm volatile("s_waitcnt vmcnt(0)" ::: "memory");
        }
    }
    __syncthreads();
}


constexpr int CT_IN = 132 * 16, CT_OUT = 32 * 16, CT_UP = 172 * 16, CT_DN = 32 * 43, CT_ALL = CT_IN + CT_OUT + CT_UP + CT_DN;
struct ConvTile { const float* W; u16* Bt; int K, Nsrc, src, nvalid, k0, n0; };
__device__ __forceinline__ ConvTile conv_decode(const Params& P, int tix) {
    ConvTile t; int nbk, kb; t.nvalid = 64;
    if (tix < CT_IN) { t.W = P.in[10]; t.Bt = (u16*)(P.ws + WS_WIN); t.K = 2048; t.Nsrc = 8208; nbk = tix >> 4; kb = tix & 15;
        const int n0 = nbk * 64, pn = n0 >> 8, p = n0 & 255;
        if (pn < 8) { const int bj = p >> 7, q = p & 127; t.src = pn * 256 + (q < 64 ? 64 * bj : 128 + 64 * bj); }
        else if (pn < 32) t.src = n0;
        else { t.src = 8192; t.nvalid = (p == 0) ? 16 : 0; } }
    else if (tix < CT_IN + CT_OUT) { const int r = tix - CT_IN; t.W = P.in[16]; t.Bt = (u16*)(P.ws + WS_WOUT); t.K = 2048; t.Nsrc = 2048; nbk = r >> 4; kb = r & 15; t.src = nbk * 64; }
    else if (tix < CT_IN + CT_OUT + CT_UP) { const int r = tix - CT_IN - CT_OUT; t.W = P.in[19]; t.Bt = (u16*)(P.ws + WS_WUP); t.K = 2048; t.Nsrc = NUP; nbk = r >> 4; kb = r & 15;
        const int n0 = nbk * 64, pn = n0 >> 8, p = n0 & 255; t.src = p < 128 ? 128 * pn + p : DFF + 128 * pn + (p - 128); }
    else { const int r = tix - CT_IN - CT_OUT - CT_UP; t.W = P.in[21]; t.Bt = (u16*)(P.ws + WS_WDN); t.K = DFF; t.Nsrc = 2048; nbk = r / 43; kb = r % 43; t.src = nbk * 64; }
    t.k0 = kb * 128; t.n0 = nbk * 64; return t;
}
__device__ __forceinline__ void conv_load(const ConvTile& t, int tid, f32x4 (&w)[4]) {
#pragma unroll
    for (int x = 0; x < 4; ++x) { const int idx = tid + 512 * x, kk = idx >> 4, c4 = idx & 15;
        w[x] = (f32x4){0.f, 0.f, 0.f, 0.f};
        if (4 * c4 < t.nvalid) w[x] = __builtin_nontemporal_load((const f32x4*)(t.W + (size_t)(t.k0 + kk) * t.Nsrc + t.src + 4 * c4)); }
}
__device__ __forceinline__ void convert_tiles(const Params& P, LAS unsigned char* lds, int t_begin, int t_end, int first, int stride) {
    const int tid = threadIdx.x;
    LAS u16* tl = (LAS u16*)lds;
    int tix = t_begin + first;
    if (tix >= t_end) return;
    f32x4 nw[4]; { const ConvTile t = conv_decode(P, tix); conv_load(t, tid, nw); }
    __syncthreads();
    for (; tix < t_end; tix += stride) {
        const ConvTile t = conv_decode(P, tix);
        f32x4 w[4];
#pragma unroll
        for (int x = 0; x < 4; ++x) w[x] = nw[x];
        if (tix + stride < t_end) { const ConvTile t2 = conv_decode(P, tix + stride); conv_load(t2, tid, nw); }
#pragma unroll
        for (int x = 0; x < 4; ++x) { const int idx = tid + 512 * x, kk = idx >> 4, c4 = idx & 15;
#pragma unroll
            for (int e = 0; e < 4; ++e) tl[(4 * c4 + e) * 132 + kk] = f2bf(w[x][e]); }
        __syncthreads();
#pragma unroll
        for (int x = 0; x < 2; ++x) { const int idx = tid + 512 * x, n = idx >> 4, ch = idx & 15;
            const u32x2 lo = *(const LAS u32x2*)(tl + n * 132 + 8 * ch), hi = *(const LAS u32x2*)(tl + n * 132 + 8 * ch + 4);
            *(u32x4*)(t.Bt + (size_t)(t.n0 + n) * t.K + t.k0 + 8 * ch) = (u32x4){lo.x, lo.y, hi.x, hi.y}; }
        __syncthreads();
    }
}

__device__ __forceinline__ void phase0(const Params& P, LAS unsigned char* lds) {
    const int tid = threadIdx.x, nb = gridDim.x, b = blockIdx.x;
    LAS float* sv = (LAS float*)lds;
    LAS float* red = (LAS float*)(lds + 24576);
    const float* c_in = P.in[6]; const float* c_ctx = P.in[7]; const float* w_mod = P.in[8]; const float* b_mod = P.in[9];
    float* mod = (float*)(P.ws + WS_MOD);
    for (int i = tid; i < 3 * 2048; i += 512) { const int v = i >> 11, k = i & 2047; const float c = v == 0 ? c_ctx[k] : c_in[(v - 1) * 2048 + k]; sv[i] = c / (1.f + expf(-c)); }
    __syncthreads();
    for (int slab = b; slab < 256; slab += nb) {
        const int cq = tid % 12, kl = tid / 12;
        float a0[4] = {0.f, 0.f, 0.f, 0.f}, a1[4] = {0.f, 0.f, 0.f, 0.f}, a2[4] = {0.f, 0.f, 0.f, 0.f};
        if (tid < 504) {
            const float* wp = w_mod + (size_t)48 * slab + 4 * cq;
#pragma unroll 7
            for (int k = kl; k < 2048; k += 42) {
                const f32x4 w = __builtin_nontemporal_load((const f32x4*)(wp + (size_t)k * 12288)); const float s0 = sv[k], s1 = sv[2048 + k], s2 = sv[4096 + k];
#pragma unroll
                for (int e = 0; e < 4; ++e) { a0[e] += s0 * w[e]; a1[e] += s1 * w[e]; a2[e] += s2 * w[e]; }
            }
#pragma unroll
            for (int e = 0; e < 4; ++e) { red[(kl * 3 + 0) * 48 + 4 * cq + e] = a0[e]; red[(kl * 3 + 1) * 48 + 4 * cq + e] = a1[e]; red[(kl * 3 + 2) * 48 + 4 * cq + e] = a2[e]; }
        }
        __syncthreads();
        if (tid < 144) { const int v = tid / 48, col = tid % 48; float s = 0.f; for (int k2 = 0; k2 < 42; ++k2) s += red[(k2 * 3 + v) * 48 + col]; mod[v * 12288 + 48 * slab + col] = s + b_mod[48 * slab + col]; }
        __syncthreads();
    }
    float2* cs = (float2*)(P.ws + WS_CS);
    for (int i = b * 512 + tid; i < 4096; i += nb * 512) { const int pos = i >> 6, j = i & 63; const float inv = exp2f(-(float)j * (13.287712379549449f / 64.f)); const float ang = (float)pos * inv;
        cs[i] = make_float2(__cosf(ang), __sinf(ang)); }
    if (nb == 256) convert_tiles(P, lds, 0, CT_IN + CT_OUT, b, nb); else convert_tiles(P, lds, 0, CT_ALL, b, nb);
}

__device__ __forceinline__ void ln_stats(const f32x4 (&v)[8], float& mu, float& rstd) {
    float s = 0.f;
#pragma unroll
    for (int i = 0; i < 8; ++i) s += (v[i][0] + v[i][1]) + (v[i][2] + v[i][3]);
    s = wave_sum(s); mu = s * (1.f / 2048.f);
    float q = 0.f;
#pragma unroll
    for (int i = 0; i < 8; ++i) { const f32x4 d = v[i] - mu; q += (d[0] * d[0] + d[1] * d[1]) + (d[2] * d[2] + d[3] * d[3]); }
    q = wave_sum(q); rstd = rsqrtf(q * (1.f / 2048.f) + 1e-6f);
}
__device__ __forceinline__ void phase1(const Params& P) {
    const int lane = threadIdx.x & 63, gw = blockIdx.x * 8 + (threadIdx.x >> 6), nw = gridDim.x * 8;
    const float* mod = (const float*)(P.ws + WS_MOD); u16* H = (u16*)(P.ws + WS_H);
    f32x4 nx[8], msh[8], msc[8]; int vcur = -1;
    if (gw < T_TOK) { const f32x4* xr = (const f32x4*)xrow(P, gw);
#pragma unroll
        for (int i = 0; i < 8; ++i) nx[i] = __builtin_nontemporal_load(xr + lane + 64 * i); }
    for (int t = gw; t < T_TOK; t += nw) {
        f32x4 v[8];
#pragma unroll
        for (int i = 0; i < 8; ++i) v[i] = nx[i];
        const int mv = modvec(t);
        if (mv != vcur) { vcur = mv; const f32x4* md = (const f32x4*)(mod + mv * 12288);
#pragma unroll
            for (int i = 0; i < 8; ++i) { msh[i] = md[lane + 64 * i]; msc[i] = md[512 + lane + 64 * i] + 1.f; } }
        if (t + nw < T_TOK) { const f32x4* xr = (const f32x4*)xrow(P, t + nw);
#pragma unroll
            for (int i = 0; i < 8; ++i) nx[i] = __builtin_nontemporal_load(xr + lane + 64 * i); }
        float mu, rstd; ln_stats(v, mu, rstd);
#pragma unroll
        for (int i = 0; i < 8; ++i) { const int col = 4 * (lane + 64 * i);
            const f32x4 h = (v[i] - mu) * rstd * msc[i] + msh[i];
            *(u32x2*)(H + (size_t)t * 2048 + col) = (u32x2){cvt_pk_bf16(h[0], h[1]), cvt_pk_bf16(h[2], h[3])}; }
    }
}
__device__ __forceinline__ void phase4(const Params& P) {
    const int lane = threadIdx.x & 63, gw = blockIdx.x * 8 + (threadIdx.x >> 6), nw = gridDim.x * 8;
    const u16* O0 = (const u16*)P.out; const u16* O1 = O0 + (size_t)T_TOK * 2048; const u16* G = (const u16*)(P.ws + WS_G); u16* H = (u16*)(P.ws + WS_H);
    u32x2 na[8], nb[8], ng[8]; f32x4 gnr[8];
#pragma unroll
    for (int grp = 0; grp < 8; ++grp) gnr[grp] = grp < 4 ? *(const f32x4*)(P.in[14] + grp * 256 + lane * 4) : *(const f32x4*)(P.in[15] + (grp - 4) * 256 + lane * 4);
    if (gw < T_TOK) {
#pragma unroll
        for (int grp = 0; grp < 8; ++grp) { const int col = grp * 256 + lane * 4;
            na[grp] = *(const u32x2*)(O0 + (size_t)gw * 2048 + col); nb[grp] = *(const u32x2*)(O1 + (size_t)gw * 2048 + col);
            ng[grp] = *(const u32x2*)(G + (grp < 4 ? 0 : SZQ) + (size_t)gw * 1024 + (grp & 3) * 256 + lane * 4); } }
    for (int t = gw; t < T_TOK; t += nw) {
        u32x2 ca[8], cb[8], cg_[8];
#pragma unroll
        for (int grp = 0; grp < 8; ++grp) { ca[grp] = na[grp]; cb[grp] = nb[grp]; cg_[grp] = ng[grp]; }
        if (t + nw < T_TOK) { const int t2 = t + nw;
#pragma unroll
            for (int grp = 0; grp < 8; ++grp) { const int col = grp * 256 + lane * 4;
                na[grp] = *(const u32x2*)(O0 + (size_t)t2 * 2048 + col); nb[grp] = *(const u32x2*)(O1 + (size_t)t2 * 2048 + col);
                ng[grp] = *(const u32x2*)(G + (grp < 4 ? 0 : SZQ) + (size_t)t2 * 1024 + (grp & 3) * 256 + lane * 4); } }
#pragma unroll
        for (int grp = 0; grp < 8; ++grp) {
            const int col = grp * 256 + lane * 4;
            const u32x2 a = ca[grp], b = cb[grp], gt = cg_[grp];
            f32x4 s; s[0] = bf2f(a.x & 0xffffu) + bf2f(b.x & 0xffffu); s[1] = bf2f(a.x >> 16) + bf2f(b.x >> 16); s[2] = bf2f(a.y & 0xffffu) + bf2f(b.y & 0xffffu); s[3] = bf2f(a.y >> 16) + bf2f(b.y >> 16);
            const float mu = wave_sum((s[0] + s[1]) + (s[2] + s[3])) * (1.f / 256.f);
            const f32x4 d = s - mu; const float rstd = rsqrtf(wave_sum((d[0] * d[0] + d[1] * d[1]) + (d[2] * d[2] + d[3] * d[3])) * (1.f / 256.f) + 1e-6f);
            const f32x4 gn = gnr[grp];
            const f32x4 o = d * rstd * gn * (f32x4){bf2f(gt.x & 0xffffu), bf2f(gt.x >> 16), bf2f(gt.y & 0xffffu), bf2f(gt.y >> 16)};
            *(u32x2*)(H + (size_t)t * 2048 + col) = (u32x2){cvt_pk_bf16(o[0], o[1]), cvt_pk_bf16(o[2], o[3])};
        }
    }
}
__device__ __forceinline__ void phase6(const Params& P) {
    const int lane = threadIdx.x & 63, gw = blockIdx.x * 8 + (threadIdx.x >> 6), nw = gridDim.x * 8;
    const float* mod = (const float*)(P.ws + WS_MOD); u16* H = (u16*)(P.ws + WS_H);
    f32x4 nx[8], msh[8], msc[8], lg_[8], lb_[8]; int vcur = -1;
#pragma unroll
    for (int i = 0; i < 8; ++i) { lg_[i] = *(const f32x4*)(P.in[17] + 4 * (lane + 64 * i)); lb_[i] = *(const f32x4*)(P.in[18] + 4 * (lane + 64 * i)); }
    if (gw < T_TOK) { const f32x4* yr = (const f32x4*)(P.out + (size_t)gw * 2048);
#pragma unroll
        for (int i = 0; i < 8; ++i) nx[i] = yr[lane + 64 * i]; }
    for (int t = gw; t < T_TOK; t += nw) {
        f32x4* yr = (f32x4*)(P.out + (size_t)t * 2048); f32x4 v[8];
#pragma unroll
        for (int i = 0; i < 8; ++i) v[i] = nx[i];
        const int mv = modvec(t);
        if (mv != vcur) { vcur = mv; const f32x4* md = (const f32x4*)(mod + mv * 12288 + 6144);
#pragma unroll
            for (int i = 0; i < 8; ++i) { msh[i] = md[lane + 64 * i]; msc[i] = md[512 + lane + 64 * i] + 1.f; } }
        if (t + nw < T_TOK) { const f32x4* y2 = (const f32x4*)(P.out + (size_t)(t + nw) * 2048);
#pragma unroll
            for (int i = 0; i < 8; ++i) nx[i] = y2[lane + 64 * i]; }
        float mu, rstd; ln_stats(v, mu, rstd);
#pragma unroll
        for (int i = 0; i < 8; ++i) { v[i] = (v[i] - mu) * rstd * lg_[i] + lb_[i]; yr[lane + 64 * i] = v[i]; }
        ln_stats(v, mu, rstd);
#pragma unroll
        for (int i = 0; i < 8; ++i) { const int col = 4 * (lane + 64 * i);
            const f32x4 h = (v[i] - mu) * rstd * msc[i] + msh[i];
            *(u32x2*)(H + (size_t)t * 2048 + col) = (u32x2){cvt_pk_bf16(h[0], h[1]), cvt_pk_bf16(h[2], h[3])}; }
    }
}
__device__ __forceinline__ void phase9(const Params& P) {
    const int lane = threadIdx.x & 63, gw = blockIdx.x * 8 + (threadIdx.x >> 6), nw = gridDim.x * 8;
    f32x4 nx[8], lg_[8], lb_[8];
#pragma unroll
    for (int i = 0; i < 8; ++i) { lg_[i] = *(const f32x4*)(P.in[22] + 4 * (lane + 64 * i)); lb_[i] = *(const f32x4*)(P.in[23] + 4 * (lane + 64 * i)); }
    if (gw < T_TOK) { const f32x4* yr = (const f32x4*)(P.out + (size_t)gw * 2048);
#pragma unroll
        for (int i = 0; i < 8; ++i) nx[i] = yr[lane + 64 * i]; }
    for (int t = gw; t < T_TOK; t += nw) {
        f32x4* yr = (f32x4*)(P.out + (size_t)t * 2048); f32x4 v[8];
#pragma unroll
        for (int i = 0; i < 8; ++i) v[i] = nx[i];
        if (t + nw < T_TOK) { const f32x4* y2 = (const f32x4*)(P.out + (size_t)(t + nw) * 2048);
#pragma unroll
            for (int i = 0; i < 8; ++i) nx[i] = y2[lane + 64 * i]; }
        float mu, rstd; ln_stats(v, mu, rstd);
#pragma unroll
        for (int i = 0; i < 8; ++i) yr[lane + 64 * i] = (v[i] - mu) * rstd * lg_[i] + lb_[i];
    }
}

__device__ __forceinline__ void conv4(const f32x4 (&v)[4], const f32x4 bprev, const f32x4 bnext, const f32x4 w0, const f32x4 w1, const f32x4 w2, int lane, int fr, f32x4 (&y)[4]) {
#pragma unroll
    for (int m = 0; m < 4; ++m)
#pragma unroll
        for (int e = 0; e < 4; ++e) {
            const float sp_ = (fr == 15) ? (m > 0 ? v[m > 0 ? m - 1 : 0][e] : 0.f) : v[m][e];
            float p = __builtin_bit_cast(float, __builtin_amdgcn_update_dpp(0, __builtin_bit_cast(int, sp_), 0x121, 0xf, 0xf, false)); if (m == 0 && fr == 0) p = bprev[e];
            const float sn_ = (fr == 0) ? (m < 3 ? v[m < 3 ? m + 1 : 3][e] : 0.f) : v[m][e];
            float q = __builtin_bit_cast(float, __builtin_amdgcn_update_dpp(0, __builtin_bit_cast(int, sn_), 0x12F, 0xf, 0xf, false)); if (m == 3 && fr == 15) q = bnext[e];
            y[m][e] = w0[e] * p + w1[e] * v[m][e] + w2[e] * q;
        }
}
struct EpiRes {
    static constexpr bool PERM = false, AFTER_DRAIN = false;
    const float* xp; const float* xs; float* out; const float* mod; int goff;
    __device__ __forceinline__ void operator()(const f32x4 (&acc)[2][2][4][2], const Unit& u, int wr, int wc, int fr, int fq) const {
        asm volatile("" : "+v"(fr), "+v"(fq));
        const int v = u.pm < 32 ? 0 : 1 + ((u.pm - 32) >> 3), col0 = u.pn * 256 + wc * 32 + 4 * fq;
        const float* gv = mod + v * 12288 + goff + col0;
        f32x4 g[2][2];
#pragma unroll
        for (int bj = 0; bj < 2; ++bj)
#pragma unroll
            for (int n = 0; n < 2; ++n) g[bj][n] = *(const f32x4*)(gv + bj * 128 + n * 16);
#pragma unroll
        for (int ai = 0; ai < 2; ++ai)
#pragma unroll
            for (int m = 0; m < 4; ++m) { const int r = u.pm * 256 + ai * 128 + wr * 64 + m * 16 + fr;
                const float* bp = (r < NPROMPT ? xp + (size_t)r * 2048 : xs + (size_t)(r - NPROMPT) * 2048) + col0; float* op = out + (size_t)r * 2048 + col0;
#pragma unroll
                for (int bj = 0; bj < 2; ++bj)
#pragma unroll
                    for (int n = 0; n < 2; ++n) { const f32x4 bs = *(const f32x4*)(bp + bj * 128 + n * 16); *(f32x4*)(op + bj * 128 + n * 16) = bs * ALPHA + g[bj][n] * acc[ai][bj][m][n]; }
                asm volatile("" ::: "memory"); }
    }
};
struct EpiUp {
    static constexpr bool PERM = true, AFTER_DRAIN = false;
    u16* act; const float* cw; LAS float* X;
    __device__ __forceinline__ void operator()(const f32x4 (&acc)[2][2][4][2], const Unit& u, int wr, int wc, int fr, int fq) const {
        asm volatile("" : "+v"(fr), "+v"(fq));
        const int lane = fq * 16 + fr, lc = wc * 32 + 8 * fq; const bool prompt = u.pm < 32;
#pragma unroll
        for (int ai = 0; ai < 2; ++ai) { const int grp = 2 * ai + wr;
            if (fr == 15 && grp < 3) { *(LAS f32x4*)(X + (2 * grp) * 256 + lc) = acc[ai][0][3][0]; *(LAS f32x4*)(X + (2 * grp) * 256 + lc + 4) = acc[ai][0][3][1]; }
            if (fr == 0 && grp > 0) { *(LAS f32x4*)(X + (2 * grp - 1) * 256 + lc) = acc[ai][0][0][0]; *(LAS f32x4*)(X + (2 * grp - 1) * 256 + lc + 4) = acc[ai][0][0][1]; } }
        LDS_SYNC();
        const int j0 = u.pn * 128 + lc;
#pragma unroll
        for (int ai = 0; ai < 2; ++ai) { const int grp = 2 * ai + wr; f32x4 res[4][2];
#pragma unroll
            for (int n = 0; n < 2; ++n) {
                f32x4 bprev = (f32x4){0.f, 0.f, 0.f, 0.f}, bnext = bprev;
                if (prompt) { if (grp > 0) bprev = *(const LAS f32x4*)(X + (2 * grp - 2) * 256 + lc + 4 * n); if (grp < 3) bnext = *(const LAS f32x4*)(X + (2 * grp + 1) * 256 + lc + 4 * n); }
                const f32x4 w0 = *(const f32x4*)(cw + j0 + 4 * n), w1 = *(const f32x4*)(cw + DFF + j0 + 4 * n), w2 = *(const f32x4*)(cw + 2 * DFF + j0 + 4 * n);
                f32x4 v[4], y[4];
#pragma unroll
                for (int m = 0; m < 4; ++m) v[m] = acc[ai][0][m][n];
                conv4(v, bprev, bnext, w0, w1, w2, lane, fr, y);
#pragma unroll
                for (int m = 0; m < 4; ++m)
#pragma unroll
                    for (int e = 0; e < 4; ++e) res[m][n][e] = silu_f(y[m][e]) * acc[ai][1][m][n][e];
            }
#pragma unroll
            for (int m = 0; m < 4; ++m) { const int r = u.pm * 256 + ai * 128 + wr * 64 + m * 16 + fr;
                *(u32x4*)(act + (size_t)r * DFF + j0) = (u32x4){pg8::cvt_pk_bf16(res[m][0][0], res[m][0][1]), pg8::cvt_pk_bf16(res[m][0][2], res[m][0][3]), pg8::cvt_pk_bf16(res[m][1][0], res[m][1][1]), pg8::cvt_pk_bf16(res[m][1][2], res[m][1][3])}; }
        }
    }
};
struct EpiIn {
    static constexpr bool PERM = true, AFTER_DRAIN = false;
    u16* qkv; u16* gbuf; float* gates; const float* b_gate; const float* cqk; const float2* cs; LAS float* X;
    __device__ __forceinline__ void operator()(const f32x4 (&acc)[2][2][4][2], const Unit& u, int wr, int wc, int fr, int fq) const {
        asm volatile("" : "+v"(fr), "+v"(fq));
        const int lane = fq * 16 + fr, cls = u.pn >> 2, hh = u.pn & 3, q0 = wc * 32 + 8 * fq; const bool prompt = u.pm < 32;
        const int rbase = u.pm * 256 + wr * 64 + fr;
        if (cls == 8) {
            if (wc == 0 && fq < 2) {
#pragma unroll
                for (int ai = 0; ai < 2; ++ai)
#pragma unroll
                    for (int m = 0; m < 4; ++m) { const int r = rbase + ai * 128 + m * 16;
#pragma unroll
                        for (int n = 0; n < 2; ++n) *(f32x4*)(gates + (size_t)r * 16 + 8 * fq + 4 * n) = acc[ai][0][m][n] + *(const f32x4*)(b_gate + 8 * fq + 4 * n); } }
        } else if (cls == 4 || cls == 5) {
#pragma unroll
            for (int ai = 0; ai < 2; ++ai) { const int grp = 2 * ai + wr;
#pragma unroll
                for (int bj = 0; bj < 2; ++bj)
#pragma unroll
                    for (int n = 0; n < 2; ++n) { const int xc = bj * 128 + q0 + 4 * n;
                        if (fr == 15 && grp < 3) *(LAS f32x4*)(X + (2 * grp) * 256 + xc) = acc[ai][bj][3][n];
                        if (fr == 0 && grp > 0) *(LAS f32x4*)(X + (2 * grp - 1) * 256 + xc) = acc[ai][bj][0][n]; } }
            LDS_SYNC();
            u16* ob = qkv + (cls == 4 ? 3 : 4) * SZQ; const float scl = cls == 4 ? 1.f : 0.0625f; const int chb = (cls == 4 ? 0 : 1024) + hh * 256;
#pragma unroll
            for (int ai = 0; ai < 2; ++ai) { const int grp = 2 * ai + wr;
#pragma unroll
                for (int bj = 0; bj < 2; ++bj) { f32x4 res[4][2];
#pragma unroll
                    for (int n = 0; n < 2; ++n) { const int xc = bj * 128 + q0 + 4 * n;
                        f32x4 bprev = (f32x4){0.f, 0.f, 0.f, 0.f}, bnext = bprev;
                        if (prompt) { if (grp > 0) bprev = *(const LAS f32x4*)(X + (2 * grp - 2) * 256 + xc); if (grp < 3) bnext = *(const LAS f32x4*)(X + (2 * grp + 1) * 256 + xc); }
                        const f32x4 w0 = *(const f32x4*)(cqk + chb + xc), w1 = *(const f32x4*)(cqk + 2048 + chb + xc), w2 = *(const f32x4*)(cqk + 4096 + chb + xc);
                        f32x4 v[4], y[4];
#pragma unroll
                        for (int m = 0; m < 4; ++m) v[m] = acc[ai][bj][m][n];
                        conv4(v, bprev, bnext, w0, w1, w2, lane, fr, y);
#pragma unroll
                        for (int m = 0; m < 4; ++m)
#pragma unroll
                            for (int e = 0; e < 4; ++e) res[m][n][e] = silu_f(y[m][e]) * scl; }
#pragma unroll
                    for (int m = 0; m < 4; ++m) { const int r = rbase + ai * 128 + m * 16;
                        *(u32x4*)(ob + (size_t)r * 1024 + hh * 256 + bj * 128 + q0) = (u32x4){pg8::cvt_pk_bf16(res[m][0][0], res[m][0][1]), pg8::cvt_pk_bf16(res[m][0][2], res[m][0][3]), pg8::cvt_pk_bf16(res[m][1][0], res[m][1][1]), pg8::cvt_pk_bf16(res[m][1][2], res[m][1][3])}; }
                } }
        } else if (cls < 2) {
            u16* ob = qkv + cls * SZQ; const float scl = cls == 0 ? 1.f : 0.0625f;
            const int d0 = (wc < 2) ? q0 : 128 + (q0 - 64), jf0 = q0 & 63, seg = (u.pm - 32) & 7;
#pragma unroll
            for (int ai = 0; ai < 2; ++ai)
#pragma unroll
                for (int m = 0; m < 4; ++m) { const int r = rbase + ai * 128 + m * 16, rl = ai * 128 + wr * 64 + m * 16 + fr;
                    f32x4 o1[2], o2[2];
#pragma unroll
                    for (int n = 0; n < 2; ++n) { const f32x4 x1 = acc[ai][0][m][n] * scl, x2 = acc[ai][1][m][n] * scl;
                        if (!prompt) { const int pos = (wc < 2) ? seg * 4 + (rl >> 6) : (rl & 63); const float* cp = (const float*)(cs + pos * 64 + jf0 + 4 * n);
                            const f32x4 ca = *(const f32x4*)cp, cb = *(const f32x4*)(cp + 4);
                            const f32x4 co = (f32x4){ca[0], ca[2], cb[0], cb[2]}, si = (f32x4){ca[1], ca[3], cb[1], cb[3]};
                            o1[n] = x1 * co - x2 * si; o2[n] = x1 * si + x2 * co; }
                        else { o1[n] = x1; o2[n] = x2; } }
                    u16* rp = ob + (size_t)r * 1024 + hh * 256 + d0;
                    *(u32x4*)rp = (u32x4){pg8::cvt_pk_bf16(o1[0][0], o1[0][1]), pg8::cvt_pk_bf16(o1[0][2], o1[0][3]), pg8::cvt_pk_bf16(o1[1][0], o1[1][1]), pg8::cvt_pk_bf16(o1[1][2], o1[1][3])};
                    *(u32x4*)(rp + 64) = (u32x4){pg8::cvt_pk_bf16(o2[0][0], o2[0][1]), pg8::cvt_pk_bf16(o2[0][2], o2[0][3]), pg8::cvt_pk_bf16(o2[1][0], o2[1][1]), pg8::cvt_pk_bf16(o2[1][2], o2[1][3])}; }
        } else {
            u16* ob = cls == 2 ? qkv + 2 * SZQ : cls == 6 ? qkv + 5 * SZQ : cls == 3 ? gbuf : gbuf + SZQ;
#pragma unroll
            for (int ai = 0; ai < 2; ++ai)
#pragma unroll
                for (int m = 0; m < 4; ++m) { const int r = rbase + ai * 128 + m * 16;
#pragma unroll
                    for (int bj = 0; bj < 2; ++bj) { f32x4 a = acc[ai][bj][m][0], b = acc[ai][bj][m][1];
                        if (cls == 3) {
#pragma unroll
                            for (int e = 0; e < 4; ++e) { a[e] = silu_f(a[e]); b[e] = silu_f(b[e]); } }
                        if (cls == 7) {
#pragma unroll
                            for (int e = 0; e < 4; ++e) { a[e] = sigm_f(a[e]); b[e] = sigm_f(b[e]); } }
                        *(u32x4*)(ob + (size_t)r * 1024 + hh * 256 + bj * 128 + q0) = (u32x4){pg8::cvt_pk_bf16(a[0], a[1]), pg8::cvt_pk_bf16(a[2], a[3]), pg8::cvt_pk_bf16(b[0], b[1]), pg8::cvt_pk_bf16(b[2], b[3])}; } }
        }
    }
};

__device__ __forceinline__ void tr_issue(s16x4& r, unsigned addr) { asm volatile("ds_read_b64_tr_b16 %0, %1" : "=v"(r) : "v"(addr) : "memory"); }

static_assert(SSTR == 176 && VSTR == 144 && KSTR == 528, "literal offsets in the asm batches");
__device__ __forceinline__ void tr_batch_s(unsigned base, s16x4 (&a)[5], s16x4 (&b)[5]) {
    asm volatile("ds_read_b64_tr_b16 %0, %10\n\tds_read_b64_tr_b16 %1, %10 offset:32\n\tds_read_b64_tr_b16 %2, %10 offset:64\n\tds_read_b64_tr_b16 %3, %10 offset:96\n\tds_read_b64_tr_b16 %4, %10 offset:128\n\t"
                 "ds_read_b64_tr_b16 %5, %10 offset:704\n\tds_read_b64_tr_b16 %6, %10 offset:736\n\tds_read_b64_tr_b16 %7, %10 offset:768\n\tds_read_b64_tr_b16 %8, %10 offset:800\n\tds_read_b64_tr_b16 %9, %10 offset:832\n\t"
                 "s_waitcnt lgkmcnt(0)"
                 : "=&v"(a[0]), "=&v"(a[1]), "=&v"(a[2]), "=&v"(a[3]), "=&v"(a[4]), "=&v"(b[0]), "=&v"(b[1]), "=&v"(b[2]), "=&v"(b[3]), "=&v"(b[4]) : "v"(base) : "memory");
}
__device__ __forceinline__ void tr_batch_v(unsigned base, s16x4 (&a)[4], s16x4 (&b)[4]) {
    asm volatile("ds_read_b64_tr_b16 %0, %8\n\tds_read_b64_tr_b16 %1, %8 offset:32\n\tds_read_b64_tr_b16 %2, %8 offset:64\n\tds_read_b64_tr_b16 %3, %8 offset:96\n\t"
                 "ds_read_b64_tr_b16 %4, %8 offset:2304\n\tds_read_b64_tr_b16 %5, %8 offset:2336\n\tds_read_b64_tr_b16 %6, %8 offset:2368\n\tds_read_b64_tr_b16 %7, %8 offset:2400\n\t"
                 "s_waitcnt lgkmcnt(0)"
                 : "=&v"(a[0]), "=&v"(a[1]), "=&v"(a[2]), "=&v"(a[3]), "=&v"(b[0]), "=&v"(b[1]), "=&v"(b[2]), "=&v"(b[3]) : "v"(base) : "memory");
}
__device__ __forceinline__ void tr_batch_kv(unsigned kb, unsigned vb, s16x4 (&k)[4], s16x4 (&a)[4], s16x4 (&b)[4]) {
    asm volatile("ds_read_b64_tr_b16 %0, %12\n\tds_read_b64_tr_b16 %1, %12 offset:2112\n\tds_read_b64_tr_b16 %2, %12 offset:32\n\tds_read_b64_tr_b16 %3, %12 offset:2144\n\t"
                 "ds_read_b64_tr_b16 %4, %13\n\tds_read_b64_tr_b16 %5, %13 offset:32\n\tds_read_b64_tr_b16 %6, %13 offset:64\n\tds_read_b64_tr_b16 %7, %13 offset:96\n\t"
                 "ds_read_b64_tr_b16 %8, %13 offset:576\n\tds_read_b64_tr_b16 %9, %13 offset:608\n\tds_read_b64_tr_b16 %10, %13 offset:640\n\tds_read_b64_tr_b16 %11, %13 offset:672\n\t"
                 "s_waitcnt lgkmcnt(0)"
                 : "=&v"(k[0]), "=&v"(k[1]), "=&v"(k[2]), "=&v"(k[3]), "=&v"(a[0]), "=&v"(a[1]), "=&v"(a[2]), "=&v"(a[3]), "=&v"(b[0]), "=&v"(b[1]), "=&v"(b[2]), "=&v"(b[3]) : "v"(kb), "v"(vb) : "memory");
}
__device__ __forceinline__ bf16x8 cat8(const s16x4 a, const s16x4 b) { return (bf16x8){a[0], a[1], a[2], a[3], b[0], b[1], b[2], b[3]}; }
#define MFMA16(a, b, c) __builtin_amdgcn_mfma_f32_16x16x32_bf16(a, b, c, 0, 0, 0)

__device__ __forceinline__ void gates_gemm(const Params& P, int pm) {
    const int tid = threadIdx.x, w = tid >> 6, lane = tid & 63, r = lane & 15, g = lane >> 4;
    const u16* a0 = (const u16*)(P.ws + WS_H) + (size_t)(pm * 256 + 32 * w + r) * 2048 + 8 * g; const u16* a1 = a0 + 16 * 2048;
    const u16* bp = (const u16*)(P.ws + WS_WIN) + (size_t)(8192 + r) * 2048 + 8 * g;
    f32x4 c0 = (f32x4){0.f, 0.f, 0.f, 0.f}, c1 = c0;
#pragma unroll 8
    for (int ks = 0; ks < 64; ++ks) { const bf16x8 A0 = *(const bf16x8*)(a0 + 32 * ks), A1 = *(const bf16x8*)(a1 + 32 * ks), B = *(const bf16x8*)(bp + 32 * ks);
        c0 = MFMA16(B, A0, c0); c1 = MFMA16(B, A1, c1); }
    float* gates = (float*)(P.ws + WS_GATES); const f32x4 bg = *(const f32x4*)(P.in[11] + 4 * g);
    *(f32x4*)(gates + (size_t)(pm * 256 + 32 * w + r) * 16 + 4 * g) = c0 + bg;
    *(f32x4*)(gates + (size_t)(pm * 256 + 32 * w + 16 + r) * 16 + 4 * g) = c1 + bg;
}
struct ScanItem { int mlstm, sample, b, dir, h, vb, L, nsteps, tok0; };
__device__ __forceinline__ ScanItem scan_decode(int id) {
    ScanItem it; int rem;
    if (id < 128) { it.sample = 1; it.mlstm = id >> 6; rem = id & 63; } else { it.sample = 0; it.mlstm = (id - 128) >> 10; rem = (id - 128) & 1023; }
    it.b = rem >> 5; it.dir = (rem >> 4) & 1; it.h = (rem >> 2) & 3; it.vb = rem & 3;
    it.L = it.sample ? 2048 : 256; it.nsteps = it.L >> 7; it.tok0 = it.sample ? NPROMPT + it.b * 2048 : it.b * 256;
    return it;
}
__device__ __forceinline__ int scan_item_at(int k) {
    const int c = blockIdx.x, G = gridDim.x; int id;
    if (G == 256) { if (c < 128) id = (k == 0) ? c : (k < 4 ? 128 + 3 * c + (k - 1) : -1); else id = (k < 13) ? 128 + 384 + 13 * (c - 128) + k : -1; }
    else { id = c + k * G; if (id >= 2176) id = -1; }
    return id;
}
#define SCAN_TB(it, step) ((it).tok0 + ((it).dir ? (it).L - 128 * ((step) + 1) : 128 * (step)))
#define TOKD(tb, dir, i) ((tb) + ((dir) ? 127 - (i) : (i)))
#define SCAN_LOADS(it, step, pk, pv, pg) do { const int tb_ = SCAN_TB(it, step); \
    const u16* KB_ = (const u16*)(P.ws + WS_QKV) + ((it).mlstm ? 4 : 1) * SZQ + (it).h * 256; const u16* VB_ = KB_ + SZQ + (it).vb * 64; \
    _Pragma("unroll") for (int x = 0; x < 8; ++x) { const int idx = tid + 512 * x, row = idx >> 5, ch = idx & 31; pk[x] = *(const u32x4*)(KB_ + (size_t)TOKD(tb_, (it).dir, row) * 1024 + ch * 8); } \
    _Pragma("unroll") for (int x = 0; x < 2; ++x) { const int idx = tid + 512 * x, row = idx >> 3, ch = idx & 7; pv[x] = *(const u32x4*)(VB_ + (size_t)TOKD(tb_, (it).dir, row) * 1024 + ch * 8); } \
    if ((it).mlstm) { const float* gp0 = gates + (size_t)TOKD(tb_, (it).dir, 2 * lane) * 16 + (it).dir * 8 + (it).h; const float* gp1 = gates + (size_t)TOKD(tb_, (it).dir, 2 * lane + 1) * 16 + (it).dir * 8 + (it).h; \
        pg[0] = gp0[0]; pg[1] = gp0[4]; pg[2] = gp1[0]; pg[3] = gp1[4]; } } while (0)
#define SCAN_QLOADS(it, step, Qr) do { const int tb_ = SCAN_TB(it, step); \
    const u16* qp = (const u16*)(P.ws + WS_QKV) + ((it).mlstm ? 3 : 0) * SZQ + (it).h * 256 + (size_t)TOKD(tb_, (it).dir, 16 * w + i16) * 1024 + 8 * g; \
    _Pragma("unroll") for (int ks = 0; ks < 8; ++ks) Qr[ks] = *(const bf16x8*)(qp + 32 * ks); } while (0)

__device__ __forceinline__ void phase3(const Params& P, LAS unsigned char* lds) {
    constexpr int NV = 5;
    const int tid0 = threadIdx.x, w = __builtin_amdgcn_readfirstlane(tid0 >> 6);
    const unsigned lbase = (unsigned)(uintptr_t)lds;
    const float* gates = (const float*)(P.ws + WS_GATES);
    LAS float* AJ = (LAS float*)(lds + L_AJ); LAS float* MI = (LAS float*)(lds + L_MI); LAS float* SPI = (LAS float*)(lds + L_SP); LAS float* EMT = (LAS float*)(lds + L_EM); LAS float* WKJ = (LAS float*)(lds + L_WK);
    int kidx = 0, id = scan_item_at(0);
    if (id < 0) return;
    ScanItem it = scan_decode(id);
    u32x4 pk[8], pv[2]; float pg[4] = {0.f, 0.f, 0.f, 0.f}; bf16x8 Qr[8];
    { const int tid = tid0, lane = tid & 63, i16 = lane & 15, g = lane >> 4; SCAN_LOADS(it, 0, pk, pv, pg); SCAN_QLOADS(it, 0, Qr); }
    for (;;) {
        const int MLSTM = it.mlstm, sample = it.sample, dir = it.dir, h = it.h, vb = it.vb;
        const int sidx = (it.b * 2 + dir) * 4 + h;
        u16* OB = (u16*)P.out + (size_t)dir * T_TOK * 2048 + (MLSTM ? 1024 : 0) + h * 256 + vb * 64;
        f32x4 accS[NV][2];
#pragma unroll
        for (int vt = 0; vt < NV; ++vt)
#pragma unroll
            for (int kk = 0; kk < 2; ++kk) accS[vt][kk] = (f32x4){0.f, 0.f, 0.f, 0.f};
        float m_run = 0.f, lg = 0.f, wk0 = 0.f, wk1 = 0.f, sc = 0.f;
        {
            const int lane = tid0 & 63, i16 = lane & 15, g = lane >> 4;
            if (sample) {
                const float* S0 = (MLSTM ? P.in[3] : P.in[2]) + (size_t)sidx * 65536 + vb * 64;
#pragma unroll
                for (int vt = 0; vt < 4; ++vt)
#pragma unroll
                    for (int kk = 0; kk < 2; ++kk) accS[vt][kk] = *(const f32x4*)(S0 + (size_t)(32 * w + 16 * kk + i16) * 256 + 16 * vt + 4 * g);
                if (MLSTM) {
#pragma unroll
                    for (int kk = 0; kk < 2; ++kk) accS[NV - 1][kk][0] = g == 0 ? P.in[4][sidx * 256 + 32 * w + 16 * kk + i16] : 0.f;
                    m_run = P.in[5][sidx]; }
            }
            if (!MLSTM) {
                lg = logsig_f(P.in[13][dir * 4 + h]);
                wk0 = expf(lg * (float)(127 - 2 * lane)); wk1 = expf(lg * (float)(126 - 2 * lane)); sc = expf(lg * 128.f);
                if (w == 0) { WKJ[2 * lane] = wk0; WKJ[2 * lane + 1] = wk1; EMT[2 * lane] = 1.f; EMT[2 * lane + 1] = 1.f; AJ[2 * lane] = -lg * (float)(2 * lane); AJ[2 * lane + 1] = -lg * (float)(2 * lane + 1); MI[2 * lane] = -lg * (float)(2 * lane); MI[2 * lane + 1] = -lg * (float)(2 * lane + 1);
                    SPI[2 * lane] = expf(lg * (float)(2 * lane + 1)); SPI[2 * lane + 1] = expf(lg * (float)(2 * lane + 2)); }
            }
#pragma unroll
            for (int vt = 0; vt < NV; ++vt)
#pragma unroll
                for (int kk = 0; kk < 2; ++kk)
                    *(LAS u32x2*)(lds + L_SS + (32 * w + 16 * kk + i16) * SSTR + (16 * vt + 4 * g) * 2) = (u32x2){cvt_pk_bf16(accS[vt][kk][0], accS[vt][kk][1]), cvt_pk_bf16(accS[vt][kk][2], accS[vt][kk][3])};
        }
        int nid = -1;
        for (int step = 0; step < it.nsteps; ++step) {
            const int tb = SCAN_TB(it, step);
            int tid = tid0; asm volatile("" : "+v"(tid));
            const int lane = tid & 63, i16 = lane & 15, g = lane >> 4, q = (lane & 15) >> 2, p = lane & 3;
            int nstep = step + 1, nxid = id; bool has_next = true;
            if (nstep == it.nsteps) { nstep = 0; nid = scan_item_at(kidx + 1); has_next = nid >= 0; nxid = nid; }
            if (MLSTM) {
                const float ig0 = pg[0], fg0 = pg[1], ig1 = pg[2], fg1 = pg[3];
                const float lf0 = logsig_f(fg0), lf1 = logsig_f(fg1), c1 = lf0 + lf1;
                float inc = c1;
#pragma unroll
                for (int o = 1; o < 64; o <<= 1) { const float t = __shfl_up(inc, o); if (lane >= o) inc += t; }
                const float b0 = inc - c1 + lf0, b1 = inc;
                const float a0 = ig0 - b0, a1 = ig1 - b1, p1 = fmaxf(a0, a1);
                float imx = p1;
#pragma unroll
                for (int o = 1; o < 64; o <<= 1) { const float t = __shfl_up(imx, o); if (lane >= o) imx = fmaxf(imx, t); }
                float emx = __shfl_up(imx, 1); if (lane == 0) emx = -INFINITY;
                const float M0 = fmaxf(m_run, fmaxf(emx, a0)), M1 = fmaxf(m_run, imx);
                const float M127 = __shfl(M1, 63), b127 = __shfl(b1, 63);
                wk0 = expf(a0 - M127); wk1 = expf(a1 - M127); sc = expf(m_run - M127);
                if (w == 0) { AJ[2 * lane] = a0; AJ[2 * lane + 1] = a1; MI[2 * lane] = M0; MI[2 * lane + 1] = M1; SPI[2 * lane] = expf(m_run - M0); SPI[2 * lane + 1] = expf(m_run - M1);
                    EMT[2 * lane] = expf(-(b0 + M0)); EMT[2 * lane + 1] = expf(-(b1 + M1)); WKJ[2 * lane] = wk0; WKJ[2 * lane + 1] = wk1; }
                m_run = b127 + M127;
            }
#pragma unroll
            for (int x = 0; x < 8; ++x) { const int idx = tid + 512 * x, row = idx >> 5, ch = idx & 31; *(LAS u32x4*)(lds + L_KS + row * KSTR + ch * 16) = pk[x]; }
#pragma unroll
            for (int x = 0; x < 2; ++x) { const int idx = tid + 512 * x, row = idx >> 3, ch = idx & 7;
                *(LAS u32x4*)(lds + L_VS + row * VSTR + ch * 16) = pv[x];
                const float wa = __shfl(wk0, (row >> 1) & 63), wb = __shfl(wk1, (row >> 1) & 63), wk = (row & 1) ? wb : wa;
                u32x4 o;
#pragma unroll
                for (int e = 0; e < 4; ++e) o[e] = cvt_pk_bf16(bf2f(pv[x][e] & 0xffffu) * wk, bf2f(pv[x][e] >> 16) * wk);
                *(LAS u32x4*)(lds + L_VW + row * VSTR + ch * 16) = o; }
            __syncthreads();
            if (has_next) { const ScanItem nit = scan_decode(nxid); SCAN_LOADS(nit, nstep, pk, pv, pg); }
            f32x4 ao[4];
#pragma unroll
            for (int vt = 0; vt < 4; ++vt) ao[vt] = (f32x4){0.f, 0.f, 0.f, 0.f};
            float rsum = 0.f;
            const int irow = 16 * w + i16; const float Mi = MI[irow];
            unsigned vbase = lbase + L_VS + (4 * g + q) * VSTR + 8 * p; asm volatile("" : "+v"(vbase));
#pragma unroll
            for (int js = 0; js < 4; ++js) {
                if (2 * js <= w) {
                    f32x4 d0 = (f32x4){0.f, 0.f, 0.f, 0.f}, d1 = d0;
                    const LAS unsigned char* kp = lds + L_KS + (32 * js + i16) * KSTR + 16 * g;
#pragma unroll
                    for (int ks = 0; ks < 8; ++ks) { const bf16x8 k0 = *(const LAS bf16x8*)(kp + 64 * ks), k1 = *(const LAS bf16x8*)(kp + 16 * KSTR + 64 * ks);
                        d0 = MFMA16(k0, Qr[ks], d0); d1 = MFMA16(k1, Qr[ks], d1); if (ks & 1) asm volatile("" ::: "memory"); }
                    const f32x4 aj0 = *(const LAS f32x4*)(AJ + 32 * js + 4 * g), aj1 = *(const LAS f32x4*)(AJ + 32 * js + 16 + 4 * g);
                    float p0[4], p1[4];
#pragma unroll
                    for (int e = 0; e < 4; ++e) { const int j0 = 32 * js + 4 * g + e, j1 = j0 + 16;
                        p0[e] = (j0 <= irow) ? d0[e] * __expf(aj0[e] - Mi) : 0.f; p1[e] = (j1 <= irow) ? d1[e] * __expf(aj1[e] - Mi) : 0.f; rsum += p0[e] + p1[e]; }
                    u32x4 pkk; pkk[0] = cvt_pk_bf16(p0[0], p0[1]); pkk[1] = cvt_pk_bf16(p0[2], p0[3]); pkk[2] = cvt_pk_bf16(p1[0], p1[1]); pkk[3] = cvt_pk_bf16(p1[2], p1[3]);
                    const bf16x8 patt = __builtin_bit_cast(bf16x8, pkk);
                    const unsigned vbs = vbase + (32 * js) * VSTR;
                    s16x4 t0[4], t1[4]; tr_batch_v(vbs, t0, t1);
#pragma unroll
                    for (int vt = 0; vt < 4; ++vt) ao[vt] = MFMA16(cat8(t0[vt], t1[vt]), patt, ao[vt]);
                }
            }
            f32x4 aqs[NV];
#pragma unroll
            for (int vt = 0; vt < NV; ++vt) aqs[vt] = (f32x4){0.f, 0.f, 0.f, 0.f};
            {
                unsigned sb = lbase + L_SS + (8 * g + q) * SSTR + 8 * p; asm volatile("" : "+v"(sb));
#pragma unroll
                for (int ks = 0; ks < 8; ++ks) {
                    s16x4 t0[NV], t1[NV]; tr_batch_s(sb + (32 * ks) * SSTR, t0, t1);
#pragma unroll
                    for (int vt = 0; vt < NV; ++vt) aqs[vt] = MFMA16(cat8(t0[vt], t1[vt]), Qr[ks], aqs[vt]);
                }
            }
            if (has_next) { const ScanItem nit = scan_decode(nxid); SCAN_QLOADS(nit, nstep, Qr); }
            {
                const float spi = SPI[irow]; float rden = 1.f;
                if (MLSTM) { rsum += __shfl_xor(rsum, 16); rsum += __shfl_xor(rsum, 32);
                    const float qn = __shfl(aqs[NV - 1][0], i16); const float den = rsum + spi * qn; rden = 1.f / fmaxf(fabsf(den), EMT[irow]); }
                u16* op = OB + (size_t)TOKD(tb, dir, irow) * 2048 + 4 * g;
#pragma unroll
                for (int vt = 0; vt < 4; ++vt) { const f32x4 o = (ao[vt] + aqs[vt] * spi) * rden; *(u32x2*)(op + 16 * vt) = (u32x2){cvt_pk_bf16(o[0], o[1]), cvt_pk_bf16(o[2], o[3])}; }
            }
#pragma unroll
            for (int vt = 0; vt < NV; ++vt)
#pragma unroll
                for (int kk = 0; kk < 2; ++kk) accS[vt][kk] *= sc;
            {
                unsigned kb_ = lbase + L_KS + (8 * g + q) * KSTR + (32 * w + 4 * p) * 2, vw_ = lbase + L_VW + (8 * g + q) * VSTR + 8 * p; asm volatile("" : "+v"(kb_), "+v"(vw_));
#pragma unroll
                for (int js = 0; js < 4; ++js) {
                    s16x4 kq[4], t0[4], t1[4]; tr_batch_kv(kb_ + (32 * js) * KSTR, vw_ + (32 * js) * VSTR, kq, t0, t1);
                    const bf16x8 kf0 = cat8(kq[0], kq[1]), kf1 = cat8(kq[2], kq[3]);
#pragma unroll
                    for (int vt = 0; vt < 4; ++vt) { const bf16x8 vf = cat8(t0[vt], t1[vt]); accS[vt][0] = MFMA16(vf, kf0, accS[vt][0]); accS[vt][1] = MFMA16(vf, kf1, accS[vt][1]); }
                    {
                        const f32x4 wa = *(const LAS f32x4*)(WKJ + 32 * js + 8 * g), wb = *(const LAS f32x4*)(WKJ + 32 * js + 8 * g + 4);
                        u32x4 pw; pw[0] = cvt_pk_bf16(wa[0], wa[1]); pw[1] = cvt_pk_bf16(wa[2], wa[3]); pw[2] = cvt_pk_bf16(wb[0], wb[1]); pw[3] = cvt_pk_bf16(wb[2], wb[3]);
                        if (i16 != 0) pw = (u32x4){0u, 0u, 0u, 0u};
                        const bf16x8 wf = __builtin_bit_cast(bf16x8, pw);
                        accS[NV - 1][0] = MFMA16(wf, kf0, accS[NV - 1][0]); accS[NV - 1][1] = MFMA16(wf, kf1, accS[NV - 1][1]);
                    }
                }
            }
            __syncthreads();
            if (step + 1 < it.nsteps) {
#pragma unroll
                for (int vt = 0; vt < NV; ++vt)
#pragma unroll
                    for (int kk = 0; kk < 2; ++kk)
                        *(LAS u32x2*)(lds + L_SS + (32 * w + 16 * kk + i16) * SSTR + (16 * vt + 4 * g) * 2) = (u32x2){cvt_pk_bf16(accS[vt][kk][0], accS[vt][kk][1]), cvt_pk_bf16(accS[vt][kk][2], accS[vt][kk][3])};
            }
        }
        if (!sample) {
            const int lane = tid0 & 63, i16 = lane & 15, g = lane >> 4;
            float* SO = P.out + (MLSTM ? OUT_C : OUT_RET) + (size_t)sidx * 65536 + vb * 64;
#pragma unroll
            for (int vt = 0; vt < 4; ++vt)
#pragma unroll
                for (int kk = 0; kk < 2; ++kk) *(f32x4*)(SO + (size_t)(32 * w + 16 * kk + i16) * 256 + 16 * vt + 4 * g) = accS[vt][kk];
            if (MLSTM && vb == 0) {
                if (g == 0) {
#pragma unroll
                    for (int kk = 0; kk < 2; ++kk) P.out[OUT_N + (size_t)sidx * 256 + 32 * w + 16 * kk + i16] = accS[NV - 1][kk][0]; }
                if (tid0 == 0) P.out[OUT_M + sidx] = m_run;
            }
        }
        if (nid < 0) break;
        id = nid; it = scan_decode(id); ++kidx;
    }
    if (gridDim.x == 256 && blockIdx.x < 128) convert_tiles(P, lds, CT_IN + CT_OUT + CT_UP, CT_ALL, blockIdx.x, 128);
}

typedef const __attribute__((address_space(4))) Params* KParams;
__device__ __forceinline__ Params kparams() {
#if defined(__HIP_DEVICE_COMPILE__)
    KParams p = (KParams)__builtin_amdgcn_kernarg_segment_ptr(); asm volatile("" : "+s"(p)); return *p;
#else
    return Params{};
#endif
}
__global__ void __launch_bounds__(512, 2) mk_fwd(Params Pk) {
    extern __shared__ __attribute__((aligned(16))) unsigned char lds_g[];
    LAS unsigned char* lds = (LAS unsigned char*)lds_g;
    const int ph_lo = Pk.ph_lo, ph_hi = Pk.ph_hi;
    volatile LAS unsigned* xst = (volatile LAS unsigned*)(lds + L_IT);
    if (threadIdx.x == 0) { xst[0] = 0u; xst[1] = 0u; }
    __syncthreads();
    const XcdBarrier xb = xcd_barrier_post((unsigned*)(Pk.ws + WS_BAR), xst);
    if (ph_hi == 12345) cg::this_grid().sync();
#define RUN(x) (ph_lo <= (x) && (x) < ph_hi && PHON(x))
#define SEAM(x) do { if (ph_lo < (x) && (x) < ph_hi) xcd_barrier(xb); } while (0)
#ifdef EXTRA_SYNCS
    for (int es = 0; es < EXTRA_SYNCS; ++es) xcd_barrier(xb);
#endif
    if (RUN(0))
_Pragma("unroll")
    for (int rep = 0; rep < NREP(0); ++rep) { if (rep) xcd_barrier(xb); const Params P = kparams(); phase0(P, lds); }
    SEAM(1);
    if (RUN(1))
_Pragma("unroll")
    for (int rep = 0; rep < NREP(1); ++rep) { if (rep) xcd_barrier(xb); const Params P = kparams(); phase1(P); }
    SEAM(2);
    if (RUN(2))
_Pragma("unroll")
    for (int rep = 0; rep < NREP(2); ++rep) { if (rep) xcd_barrier(xb); const Params P = kparams(); const float* mod = (const float*)(P.ws + WS_MOD); (void)mod;
        pg8::Gemm g{(const u16*)(P.ws + WS_H), (const u16*)(P.ws + WS_WIN), T_TOK, 8192, 2048};
        pg8::StaticOrder S; S.init(T_TOK, 8192, gridDim.x, blockIdx.x);
        EpiIn E{(u16*)(P.ws + WS_QKV), (u16*)(P.ws + WS_G), (float*)(P.ws + WS_GATES), P.in[11], P.in[12], (const float2*)(P.ws + WS_CS), (LAS float*)(lds + LDS_X)};
        pg8::gemm_phase<EpiIn, pg8::StaticOrder, true, true>(lds, g, S, E);
        for (int pm = blockIdx.x; pm < 48; pm += gridDim.x) gates_gemm(P, pm);
    }
    SEAM(3);
    if (RUN(3))
_Pragma("unroll")
    for (int rep = 0; rep < NREP(3); ++rep) { if (rep) xcd_barrier(xb); const Params P = kparams(); phase3(P, lds); }
    SEAM(4);
    if (RUN(4))
_Pragma("unroll")
    for (int rep = 0; rep < NREP(4); ++rep) { if (rep) xcd_barrier(xb); const Params P = kparams(); phase4(P); }
    SEAM(5);
    if (RUN(5))
_Pragma("unroll")
    for (int rep = 0; rep < NREP(5); ++rep) { if (rep) xcd_barrier(xb); const Params P = kparams(); const float* mod = (const float*)(P.ws + WS_MOD); (void)mod;
        pg8::Gemm g{(const u16*)(P.ws + WS_H), (const u16*)(P.ws + WS_WOUT), T_TOK, 2048, 2048};
        pg8::StaticOrder S; S.init(T_TOK, 2048, gridDim.x, blockIdx.x);
        EpiRes E{P.in[0], P.in[1], P.out, mod, 4096};
        pg8::gemm_phase<EpiRes, pg8::StaticOrder, true, true>(lds, g, S, E);
        if (gridDim.x == 256 && blockIdx.x >= 128) convert_tiles(P, lds, CT_IN + CT_OUT, CT_IN + CT_OUT + CT_UP, blockIdx.x - 128, 128);
    }
    SEAM(6);
    if (RUN(6))
_Pragma("unroll")
    for (int rep = 0; rep < NREP(6); ++rep) { if (rep) xcd_barrier(xb); const Params P = kparams(); phase6(P); }
    SEAM(7);
    if (RUN(7))
_Pragma("unroll")
    for (int rep = 0; rep < NREP(7); ++rep) { if (rep) xcd_barrier(xb); const Params P = kparams(); const float* mod = (const float*)(P.ws + WS_MOD); (void)mod;
        pg8::Gemm g{(const u16*)(P.ws + WS_H), (const u16*)(P.ws + WS_WUP), T_TOK, NUP, 2048};
        pg8::StaticOrder S; S.init(T_TOK, NUP, gridDim.x, blockIdx.x);
        EpiUp E{(u16*)(P.ws + WS_ACT), P.in[20], (LAS float*)(lds + LDS_X)};
        pg8::gemm_phase<EpiUp, pg8::StaticOrder, true, true>(lds, g, S, E);
    }
    SEAM(8);
    if (RUN(8))
_Pragma("unroll")
    for (int rep = 0; rep < NREP(8); ++rep) { if (rep) xcd_barrier(xb); const Params P = kparams(); const float* mod = (const float*)(P.ws + WS_MOD); (void)mod;
        pg8::Gemm g{(const u16*)(P.ws + WS_ACT), (const u16*)(P.ws + WS_WDN), T_TOK, 2048, DFF};
        pg8::StaticOrder S; S.init(T_TOK, 2048, gridDim.x, blockIdx.x);
        EpiRes E{P.out, P.out + (size_t)NPROMPT * 2048, P.out, mod, 10240};
        pg8::gemm_phase<EpiRes, pg8::StaticOrder, true, true>(lds, g, S, E);
    }
    SEAM(9);
    if (RUN(9))
_Pragma("unroll")
    for (int rep = 0; rep < NREP(9); ++rep) { if (rep) xcd_barrier(xb); const Params P = kparams(); phase9(P); }
}

extern "C" void kernel_launch(void* const* d_in, const int* in_sizes, int n_in, void* d_out, int out_size, void* d_ws, size_t ws_size, hipStream_t stream) {
    static int grid = 0;
    if (grid == 0) {
        if (n_in != 24 || ws_size < WS_END2) { fprintf(stderr, "kernel_launch: unexpected n_in %d / ws_size %zu (need %zu)\n", n_in, ws_size, (size_t)WS_END2); grid = -1; return; }
        int dev = 0, cus = 0, per_cu = 0;
        hipGetDevice(&dev); hipDeviceGetAttribute(&cus, hipDeviceAttributeMultiprocessorCount, dev);
        if (hipFuncSetAttribute((const void*)mk_fwd, hipFuncAttributeMaxDynamicSharedMemorySize, LDS_BYTES) != hipSuccess) { fprintf(stderr, "kernel_launch: hipFuncSetAttribute failed\n"); grid = -1; return; }
        if (hipOccupancyMaxActiveBlocksPerMultiprocessor(&per_cu, (const void*)mk_fwd, 512, LDS_BYTES) != hipSuccess || per_cu < 1) { fprintf(stderr, "kernel_launch: occupancy query gives %d\n", per_cu); per_cu = 1; }
        (void)hipGetLastError();
        grid = cus;
        if (grid < 1) grid = 256;
    }
    if (grid < 0) return;
    if (hipMemsetAsync((char*)d_ws + WS_BAR, 0, XCD_BAR_WORDS * 4, stream) != hipSuccess) { fprintf(stderr, "kernel_launch: memset of the barrier words failed\n"); return; }
    Params p{};
    for (int i = 0; i < 24; ++i) p.in[i] = (const float*)d_in[i];
    p.out = (float*)d_out; p.ws = (unsigned char*)d_ws;
#if PER_PHASE
    for (int ph = 0; ph < MAXPH; ++ph) { p.ph_lo = ph; p.ph_hi = ph + 1; hipLaunchKernelGGL(mk_fwd, dim3(grid), dim3(512), LDS_BYTES, stream, p); }
#else
    p.ph_lo = 0; p.ph_hi = MAXPH;
    void* args[] = {&p};
    hipError_t e = hipLaunchCooperativeKernel((const void*)mk_fwd, dim3(grid), dim3(512), args, LDS_BYTES, stream);
    if (e != hipSuccess) fprintf(stderr, "cooperative launch failed: %s (grid %d)\n", hipGetErrorString(e), grid);
#endif
}
```
